# Optimizing an MI355X kernel written in HIP

```python
import jax
import jax.numpy as jnp
from jax import lax
import numpy as np

D_MODEL = 1024
BATCH = 4
SEQ = 8192
DEPTH = 2

GRID_W = 64
CTX_LEN = 256
HEAD_DIM = 64
N_GROUPS = 4
GROUP_WIDTH = D_MODEL // N_GROUPS
D_MIX = N_GROUPS * GROUP_WIDTH
N_Q_HEADS = GROUP_WIDTH // HEAD_DIM
N_KV_HEADS = 2
KV_W = N_KV_HEADS * HEAD_DIM
WINDOW = 128
BLOCK = 128
NA_KH = 8
NA_KW = 16
LRU_BLOCKS = 4
LRU_BW = GROUP_WIDTH // LRU_BLOCKS
LRU_C = 8.0
CONV_W = 4
PEER_HEADS = 8
PEER_KEYS = 128
PEER_EXPERTS = PEER_KEYS * PEER_KEYS
PEER_DKEY = 256
PEER_TOPK = 16
ROPE_BASE = 10000.0
EPS = 1e-6
NEG = -1e30
IN_WIDTHS = (GROUP_WIDTH, KV_W, KV_W,
             GROUP_WIDTH, KV_W, KV_W,
             GROUP_WIDTH, GROUP_WIDTH, GROUP_WIDTH,
             GROUP_WIDTH, GROUP_WIDTH)
D_IN = 7 * GROUP_WIDTH + 4 * KV_W

kernel_name = 'hybrid_flow_backbone'


def rmsnorm(x, g):
    x32 = x.astype(jnp.float32)
    y = x32 * lax.rsqrt(jnp.mean(x32 * x32, axis=-1, keepdims=True) + EPS)
    return y.astype(x.dtype) * g


def heads(t, n):
    return t.reshape(t.shape[:-1] + (n, HEAD_DIM))


def split_in(z):
    bounds = np.cumsum(IN_WIDTHS)[:-1].tolist()
    return jnp.split(z, bounds, axis=-1)


def rope1d(x, pos):
    half = x.shape[-1] // 2
    inv = ROPE_BASE ** (-jnp.arange(half, dtype=jnp.float32) / half)
    ang = pos.astype(jnp.float32)[:, None] * inv
    cos = jnp.cos(ang)[:, None, :]
    sin = jnp.sin(ang)[:, None, :]
    x1 = x[..., :half].astype(jnp.float32)
    x2 = x[..., half:].astype(jnp.float32)
    return jnp.concatenate([x1 * cos - x2 * sin, x1 * sin + x2 * cos], axis=-1).astype(x.dtype)


def rope2d(x, rows, cols):
    h = x.shape[-1] // 2
    return jnp.concatenate([rope1d(x[..., :h], rows), rope1d(x[..., h:], cols)], axis=-1)


def context_attention(qc, kc, vc, sink=None):
    B, Lc, Hq, _ = qc.shape
    Hkv = kc.shape[2]
    G = Hq // Hkv
    qg = qc.reshape(B, Lc, Hkv, G, HEAD_DIM)
    s = jnp.einsum('bqkgd,bskd->bkgqs', qg, kc).astype(jnp.float32) * HEAD_DIM ** -0.5
    if sink is not None:
        col = jnp.broadcast_to(sink.astype(jnp.float32).reshape(Hkv, G, 1, 1), s.shape[:-1] + (1,))
        s = jnp.concatenate([s, col], axis=-1)
    p = jax.nn.softmax(s, axis=-1)[..., :Lc].astype(vc.dtype)
    o = jnp.einsum('bkgqs,bskd->bqkgd', p, vc)
    return o.reshape(B, Lc, Hq * HEAD_DIM)


def window_attention(q, k, v, qc, kc, vc, sink, rows, cols, ctx_out):
    B, L = q.shape[:2]
    Lc = kc.shape[1]
    nb = L // BLOCK
    G = N_Q_HEADS // N_KV_HEADS
    S = 3 * BLOCK
    q = rope2d(q, rows, cols)
    k = rope2d(k, rows, cols)
    qb = q.reshape(B, nb, BLOCK, N_KV_HEADS, G, HEAD_DIM)
    pad = ((0, 0), (BLOCK, BLOCK), (0, 0), (0, 0))
    kp = jnp.pad(k, pad).reshape(B, nb + 2, BLOCK, N_KV_HEADS, HEAD_DIM)
    vp = jnp.pad(v, pad).reshape(B, nb + 2, BLOCK, N_KV_HEADS, HEAD_DIM)
    kb = jnp.concatenate([kp[:, :-2], kp[:, 1:-1], kp[:, 2:]], axis=2)
    vb = jnp.concatenate([vp[:, :-2], vp[:, 1:-1], vp[:, 2:]], axis=2)
    qi = jnp.arange(BLOCK)[:, None]
    kj = jnp.arange(S)[None, :]
    rel = kj - BLOCK - qi
    kpos = jnp.arange(nb)[:, None, None] * BLOCK + kj[None] - BLOCK
    mask = (jnp.abs(rel) <= WINDOW)[None] & (kpos >= 0) & (kpos < L)
    scale = HEAD_DIM ** -0.5
    s_loc = jnp.einsum('bnqkgd,bnskd->bnkgqs', qb, kb).astype(jnp.float32) * scale
    s_loc = jnp.where(mask[None, :, None, None], s_loc, NEG)
    s_ctx = jnp.einsum('bnqkgd,bskd->bnkgqs', qb, kc).astype(jnp.float32) * scale
    sink_col = jnp.broadcast_to(sink.astype(jnp.float32).reshape(N_KV_HEADS, G, 1, 1), s_loc.shape[:-1] + (1,))
    p = jax.nn.softmax(jnp.concatenate([s_loc, s_ctx, sink_col], axis=-1), axis=-1).astype(v.dtype)
    o = (jnp.einsum('bnkgqs,bnskd->bnqkgd', p[..., :S], vb)
         + jnp.einsum('bnkgqs,bskd->bnqkgd', p[..., S:S + Lc], vc))
    y = o.reshape(B, L, N_Q_HEADS * HEAD_DIM)
    yc = context_attention(qc, kc, vc, sink) if ctx_out else None
    return y, yc


def global_attention(q, k, v, qc, kc, vc, gq, gk, rows, cols, ctx_out):
    B, L = q.shape[:2]
    nb = L // BLOCK
    G = N_Q_HEADS // N_KV_HEADS
    q = rope2d(rmsnorm(q, gq), rows, cols)
    k = rope2d(rmsnorm(k, gk), rows, cols)
    qc = rmsnorm(qc, gq)
    kc = rmsnorm(kc, gk)
    k_all = jnp.concatenate([k, kc], axis=1)
    v_all = jnp.concatenate([v, vc], axis=1)
    qb = q.reshape(B, nb, BLOCK, N_KV_HEADS, G, HEAD_DIM).transpose(1, 0, 2, 3, 4, 5)

    def attend_block(qblk):
        s = jnp.einsum('bqkgd,bskd->bkgqs', qblk, k_all).astype(jnp.float32) * HEAD_DIM ** -0.5
        p = jax.nn.softmax(s, axis=-1).astype(v_all.dtype)
        return jnp.einsum('bkgqs,bskd->bqkgd', p, v_all)

    o = lax.map(attend_block, qb)
    y = o.transpose(1, 0, 2, 3, 4, 5).reshape(B, L, N_Q_HEADS * HEAD_DIM)
    yc = context_attention(qc, kc, vc) if ctx_out else None
    return y, yc


def neighbourhood_attention(q, k, v, qc, kc, vc, rel_bias, ctx_out):
    B, L, H, d = q.shape
    R = L // GRID_W
    KH = min(NA_KH, R)
    S = KH * GRID_W
    r_idx = jnp.arange(R)
    key_rows = jnp.clip(r_idx - KH // 2, 0, R - KH)[:, None] + jnp.arange(KH)[None, :]
    c_idx = jnp.arange(GRID_W)
    col_start = jnp.clip(c_idx - NA_KW // 2, 0, GRID_W - NA_KW)
    col_mask = (c_idx[None, :] >= col_start[:, None]) & (c_idx[None, :] < col_start[:, None] + NA_KW)
    mask = jnp.broadcast_to(col_mask[:, None, :], (GRID_W, KH, GRID_W)).reshape(GRID_W, S)
    dr = key_rows - r_idx[:, None]
    dc = jnp.clip(c_idx[None, :] - c_idx[:, None], -(NA_KW - 1), NA_KW - 1)
    bias = rel_bias[:, dr[:, None, :, None] + (NA_KH - 1), dc[None, :, None, :] + (NA_KW - 1)]
    bias = bias.reshape(H, R, GRID_W, S).transpose(1, 0, 2, 3).astype(jnp.float32)
    qg = q.reshape(B, R, GRID_W, H, d)
    kg = k.reshape(B, R, GRID_W, H, d)[:, key_rows].reshape(B, R, S, H, d)
    vg = v.reshape(B, R, GRID_W, H, d)[:, key_rows].reshape(B, R, S, H, d)
    scale = d ** -0.5
    s_loc = jnp.einsum('brqhd,brshd->brhqs', qg, kg).astype(jnp.float32) * scale + bias
    s_loc = jnp.where(mask, s_loc, NEG)
    s_ctx = jnp.einsum('brqhd,bshd->brhqs', qg, kc).astype(jnp.float32) * scale
    p = jax.nn.softmax(jnp.concatenate([s_loc, s_ctx], axis=-1), axis=-1).astype(v.dtype)
    o = (jnp.einsum('brhqs,brshd->brqhd', p[..., :S], vg)
         + jnp.einsum('brhqs,bshd->brqhd', p[..., S:], vc))
    y = o.reshape(B, L, H * d)
    yc = context_attention(qc, kc, vc) if ctx_out else None
    return y, yc


def dwconv(x, w, b):
    L = x.shape[1]
    lpad = CONV_W // 2
    xp = jnp.pad(x, ((0, 0), (lpad, CONV_W - 1 - lpad), (0, 0)))
    return sum(xp[:, j:j + L] * w[j] for j in range(CONV_W)) + b


def rglru_coeffs(u, w_a, b_a, w_x, b_x, lam):
    B, L, C = u.shape
    ub = u.reshape(B, L, LRU_BLOCKS, LRU_BW)
    r = jax.nn.sigmoid((jnp.einsum('blnc,ncd->blnd', ub, w_a).reshape(B, L, C) + b_a).astype(jnp.float32))
    i = jax.nn.sigmoid((jnp.einsum('blnc,ncd->blnd', ub, w_x).reshape(B, L, C) + b_x).astype(jnp.float32))
    log_a = -LRU_C * r * jax.nn.softplus(-lam.astype(jnp.float32))
    a = jnp.exp(log_a)
    b = jnp.sqrt(-jnp.expm1(2.0 * log_a)) * (i * u.astype(jnp.float32))
    return a, b


def linear_scan(a, b, h0):
    def combine(lhs, rhs):
        a1, b1 = lhs
        a2, b2 = rhs
        return a1 * a2, a2 * b1 + b2
    a_cum, b_cum = lax.associative_scan(combine, (a, b), axis=1)
    return a_cum * h0[:, None, :] + b_cum


def flip_if(t, rev):
    return jnp.flip(t, axis=1) if rev else t


def recurrent_mixer(xr, xg, xrc, xgc, conv_w, conv_b, w_a, b_a, w_x, b_x, lam, ctx_out):
    u = dwconv(xr, conv_w, conv_b)
    uc = dwconv(xrc, conv_w, conv_b)
    B, _, C = u.shape
    ys, ycs = [], []
    for d in range(2):
        ac, bc = rglru_coeffs(flip_if(uc, d), w_a[d], b_a[d], w_x[d], b_x[d], lam[d])
        hc = linear_scan(ac, bc, jnp.zeros((B, C), jnp.float32))
        a, b = rglru_coeffs(flip_if(u, d), w_a[d], b_a[d], w_x[d], b_x[d], lam[d])
        h = linear_scan(a, b, hc[:, -1])
        ys.append(flip_if(h, d))
        ycs.append(flip_if(hc, d))
    y = (ys[0] + ys[1]).astype(xr.dtype) * jax.nn.gelu(xg)
    yc = (ycs[0] + ycs[1]).astype(xrc.dtype) * jax.nn.gelu(xgc) if ctx_out else None
    return y, yc


def peer_ffn(h, w_query, sub_keys, u, v):
    B, L, D = h.shape
    q = (h @ w_query).reshape(B, L, PEER_HEADS, 2, PEER_DKEY // 2)
    s = jnp.einsum('blhpc,pkc->blhpk', q, sub_keys).astype(jnp.float32)
    s_top, i_top = lax.top_k(s, PEER_TOPK)
    cand_s = s_top[..., 0, :, None] + s_top[..., 1, None, :]
    cand_i = i_top[..., 0, :, None] * PEER_KEYS + i_top[..., 1, None, :]
    best_s, best_pos = lax.top_k(cand_s.reshape(B, L, PEER_HEADS, PEER_TOPK * PEER_TOPK), PEER_TOPK)
    experts = jnp.take_along_axis(cand_i.reshape(B, L, PEER_HEADS, PEER_TOPK * PEER_TOPK), best_pos, axis=-1)
    gates = jax.nn.softmax(best_s, axis=-1).astype(h.dtype)
    nb = B * (L // BLOCK)
    xs = h.reshape(nb, BLOCK, D)
    es = experts.reshape(nb, BLOCK, PEER_HEADS * PEER_TOPK)
    gs = gates.reshape(nb, BLOCK, PEER_HEADS * PEER_TOPK)

    def expert_block(args):
        xb, eb, gb = args
        act = jax.nn.gelu(jnp.einsum('td,tkd->tk', xb, u[eb]))
        return jnp.einsum('tk,tkd->td', act * gb, v[eb])

    return lax.map(expert_block, (xs, es, gs)).reshape(B, L, D)


def layer(x, xc, c, c_ctx, w_mod, b_mod, g_mix, g_ffn, w_in, w_out, sink, qn_g, kn_g, na_bias,
          conv_w, conv_b, lru_wa, lru_ba, lru_wx, lru_bx, lru_lam, peer_wq, peer_keys, peer_u, peer_v,
          rows, cols, ctx_out):
    mod = jax.nn.silu(c) @ w_mod + b_mod
    mod_c = jax.nn.silu(c_ctx) @ w_mod + b_mod
    sh1, sc1, gt1, sh2, sc2, gt2 = jnp.split(mod[:, None, :], 6, axis=-1)
    shc1, scc1, gtc1, shc2, scc2, gtc2 = jnp.split(mod_c, 6)
    h = rmsnorm(x, g_mix) * (1 + sc1) + sh1
    hc = rmsnorm(xc, g_mix) * (1 + scc1) + shc1
    qa, ka, va, qb, kb, vb, qn, kn, vn, xr, xg = split_in(h @ w_in)
    qac, kac, vac, qbc, kbc, vbc, qnc, knc, vnc, xrc, xgc = split_in(hc @ w_in)
    ya, yac = window_attention(heads(qa, N_Q_HEADS), heads(ka, N_KV_HEADS), heads(va, N_KV_HEADS),
                               heads(qac, N_Q_HEADS), heads(kac, N_KV_HEADS), heads(vac, N_KV_HEADS),
                               sink, rows, cols, ctx_out)
    yb, ybc = global_attention(heads(qb, N_Q_HEADS), heads(kb, N_KV_HEADS), heads(vb, N_KV_HEADS),
                               heads(qbc, N_Q_HEADS), heads(kbc, N_KV_HEADS), heads(vbc, N_KV_HEADS),
                               qn_g, kn_g, rows, cols, ctx_out)
    yn, ync = neighbourhood_attention(heads(qn, N_Q_HEADS), heads(kn, N_Q_HEADS), heads(vn, N_Q_HEADS),
                                      heads(qnc, N_Q_HEADS), heads(knc, N_Q_HEADS), heads(vnc, N_Q_HEADS),
                                      na_bias, ctx_out)
    yr, yrc = recurrent_mixer(xr, xg, xrc, xgc, conv_w, conv_b, lru_wa, lru_ba, lru_wx, lru_bx, lru_lam, ctx_out)
    x = x + gt1 * (jnp.concatenate([ya, yb, yn, yr], axis=-1) @ w_out)
    h2 = rmsnorm(x, g_ffn) * (1 + sc2) + sh2
    x = x + gt2 * peer_ffn(h2, peer_wq, peer_keys, peer_u, peer_v)
    if ctx_out:
        xc = xc + gtc1 * (jnp.concatenate([yac, ybc, ync, yrc], axis=-1) @ w_out)
        h2c = rmsnorm(xc, g_ffn) * (1 + scc2) + shc2
        xc = xc + gtc2 * peer_ffn(h2c, peer_wq, peer_keys, peer_u, peer_v)
    return x, xc


def setup_inputs(seed: int = 0) -> dict:
    key = jax.random.key(seed)
    ks = jax.random.split(key, 26)
    f32 = jnp.float32
    D = D_MODEL

    def nrm(k, shape, scale):
        return jax.random.normal(k, shape, f32) * scale

    a0 = jax.random.uniform(ks[20], (DEPTH, 2, GROUP_WIDTH), f32, 0.9, 0.999)
    sig = a0 ** (1.0 / LRU_C)
    lru_lam = jnp.log(sig) - jnp.log1p(-sig)
    return {
        'x': nrm(ks[0], (BATCH, SEQ, D), 1.0),
        'c': nrm(ks[1], (BATCH, D), 1.0),
        'ctx': nrm(ks[2], (BATCH, CTX_LEN, D), 1.0),
        'c_ctx': nrm(ks[3], (D,), 1.0),
        'w_mod': nrm(ks[4], (DEPTH, D, 6 * D), 0.5 * D ** -0.5),
        'b_mod': nrm(ks[5], (DEPTH, 6 * D), 0.02),
        'norm_mix': 1.0 + nrm(ks[6], (DEPTH, D), 0.02),
        'norm_ffn': 1.0 + nrm(ks[7], (DEPTH, D), 0.02),
        'w_in': nrm(ks[8], (DEPTH, D, D_IN), D ** -0.5),
        'w_out': nrm(ks[9], (DEPTH, D_MIX, D), D_MIX ** -0.5),
        'attn_sink': nrm(ks[10], (DEPTH, N_Q_HEADS), 0.5),
        'qk_norm_q': 1.0 + nrm(ks[11], (DEPTH, HEAD_DIM), 0.02),
        'qk_norm_k': 1.0 + nrm(ks[12], (DEPTH, HEAD_DIM), 0.02),
        'na_bias': nrm(ks[13], (DEPTH, N_Q_HEADS, 2 * NA_KH - 1, 2 * NA_KW - 1), 0.1),
        'conv_w': nrm(ks[14], (DEPTH, CONV_W, GROUP_WIDTH), CONV_W ** -0.5),
        'conv_b': nrm(ks[15], (DEPTH, GROUP_WIDTH), 0.02),
        'lru_wa': nrm(ks[16], (DEPTH, 2, LRU_BLOCKS, LRU_BW, LRU_BW), LRU_BW ** -0.5),
        'lru_ba': nrm(ks[17], (DEPTH, 2, GROUP_WIDTH), 0.02),
        'lru_wx': nrm(ks[18], (DEPTH, 2, LRU_BLOCKS, LRU_BW, LRU_BW), LRU_BW ** -0.5),
        'lru_bx': nrm(ks[19], (DEPTH, 2, GROUP_WIDTH), 0.02),
        'lru_lam': lru_lam,
        'peer_wq': nrm(ks[21], (DEPTH, D, PEER_HEADS * PEER_DKEY), D ** -0.5),
        'peer_keys': nrm(ks[22], (DEPTH, 2, PEER_KEYS, PEER_DKEY // 2), (PEER_DKEY // 2) ** -0.5),
        'peer_u': nrm(ks[23], (DEPTH, PEER_EXPERTS, D), D ** -0.5),
        'peer_v': nrm(ks[24], (DEPTH, PEER_EXPERTS, D), PEER_HEADS ** -0.5),
        'norm_final': 1.0 + nrm(ks[25], (D,), 0.02),
    }


def reference(x, c, ctx, c_ctx, w_mod, b_mod, norm_mix, norm_ffn, w_in, w_out, attn_sink,
              qk_norm_q, qk_norm_k, na_bias, conv_w, conv_b, lru_wa, lru_ba, lru_wx, lru_bx, lru_lam,
              peer_wq, peer_keys, peer_u, peer_v, norm_final):
    L = x.shape[1]
    t = jnp.arange(L, dtype=jnp.int32)
    rows = t // GRID_W
    cols = t % GRID_W
    xc = ctx
    for l in range(DEPTH):
        x, xc = layer(x, xc, c, c_ctx, w_mod[l], b_mod[l], norm_mix[l], norm_ffn[l], w_in[l], w_out[l],
                      attn_sink[l], qk_norm_q[l], qk_norm_k[l], na_bias[l], conv_w[l], conv_b[l],
                      lru_wa[l], lru_ba[l], lru_wx[l], lru_bx[l], lru_lam[l],
                      peer_wq[l], peer_keys[l], peer_u[l], peer_v[l], rows, cols, l < DEPTH - 1)
    return rmsnorm(x, norm_final)
```

```cpp
#include <hip/hip_runtime.h>
#include <hip/hip_cooperative_groups.h>
#include <cstdio>
#include <cstdint>
namespace cg = cooperative_groups;

typedef unsigned short bf16;
typedef __bf16 bf2_t __attribute__((ext_vector_type(2)));
typedef unsigned u4v __attribute__((ext_vector_type(4)));

constexpr int D = 1024, NB = 4, SEQ = 8192, LC = 256, TB = SEQ + LC  , M = NB * TB  ;
constexpr int DIN = 2304, ZP = 1792;
constexpr int NE = 16384;
constexpr int ZQA = 0, ZKA = 256, ZQB = 384, ZKB = 640, ZQN = 768, ZKN = 1024, ZXR = 1280, ZXG = 1536;
constexpr float EPS = 1e-6f;

constexpr size_t al(size_t x) { return (x + 255) & ~(size_t)255; }
constexpr size_t WS_CTL = 0;
constexpr size_t WS_WIN = 4096;
constexpr size_t WS_WOUT = WS_WIN + al((size_t)2 * DIN * D * 2);
constexpr size_t WS_WQ = WS_WOUT + al((size_t)2 * D * D * 2);
constexpr size_t WS_KEYS = WS_WQ + al((size_t)2 * 2048 * D * 2);
constexpr size_t WS_LRUW = WS_KEYS + al((size_t)2 * 2 * 128 * 128 * 2);
constexpr size_t WS_U = WS_LRUW + al((size_t)2 * 2 * 2 * 4 * 4096 * 2);
constexpr size_t WS_V = WS_U + al((size_t)2 * NE * D);
constexpr size_t WS_US = WS_V + al((size_t)2 * NE * D);
constexpr size_t WS_VS = WS_US + al((size_t)2 * NE * 4);
constexpr size_t WS_MOD = WS_VS + al((size_t)2 * NE * 4);
constexpr size_t WS_ROPE = WS_MOD + al((size_t)2 * 5 * 6144 * 4);
constexpr size_t WS_H = WS_ROPE + al((size_t)128 * 16 * 8);
constexpr size_t WS_Z = WS_H + al((size_t)M * D * 2);
constexpr size_t WS_VTA = WS_Z + al((size_t)M * ZP * 2);
constexpr size_t WS_VTB = WS_VTA + al((size_t)NB * 2 * 64 * TB * 2);
constexpr size_t WS_VTN = WS_VTB + al((size_t)NB * 2 * 64 * TB * 2);
constexpr size_t WS_Y = WS_VTN + al((size_t)NB * 4 * 64 * TB * 2);
constexpr size_t WS_HF = WS_Y + al((size_t)M * D * 2);
constexpr size_t WS_AGG = WS_HF + al((size_t)2 * M * 256 * 4);
constexpr size_t WS_XC = WS_AGG + al((size_t)16 * 2 * 12 * 2 * 64 * 4);
constexpr size_t WS_END = WS_XC + al((size_t)NB * LC * D * 4);
constexpr size_t WS_STOP = WS_Z;
constexpr size_t WS_ITOP = WS_Z + al((size_t)M * 256 * 4);

struct Params {
    const float *x, *c, *ctx, *c_ctx, *w_mod, *b_mod, *norm_mix, *norm_ffn, *w_in, *w_out, *attn_sink, *qn_g, *kn_g, *na_bias,
        *conv_w, *conv_b, *lru_wa, *lru_ba, *lru_wx, *lru_bx, *lru_lam, *peer_wq, *peer_keys, *peer_u, *peer_v, *norm_final;
    float* out;
    unsigned char* ws;
};

__device__ __forceinline__ float bf2f(bf16 v) { return __uint_as_float((unsigned)v << 16); }
__device__ __forceinline__ bf16 f2bf(float f) { unsigned u = __float_as_uint(f); return (bf16)((u + 0x7fffu + ((u >> 16) & 1u)) >> 16); }
typedef __bf16 bf16x2_t __attribute__((ext_vector_type(2)));
typedef float f32x2_t __attribute__((ext_vector_type(2)));
__device__ __forceinline__ unsigned pk2(float lo, float hi) { f32x2_t v = {lo, hi}; return __builtin_bit_cast(unsigned, __builtin_convertvector(v, bf16x2_t)); }
__device__ __forceinline__ float lo16(unsigned w) { return __uint_as_float(w << 16); }
__device__ __forceinline__ float hi16(unsigned w) { return __uint_as_float(w & 0xffff0000u); }
__device__ __forceinline__ float dot2(unsigned a, unsigned b, float c) { return __builtin_amdgcn_fdot2_f32_bf16(__builtin_bit_cast(bf2_t, a), __builtin_bit_cast(bf2_t, b), c, false); }
__device__ __forceinline__ float dot8(uint4 a, uint4 b, float c) { c = dot2(a.x, b.x, c); c = dot2(a.y, b.y, c); c = dot2(a.z, b.z, c); return dot2(a.w, b.w, c); }
__device__ __forceinline__ float wave_sum(float v) {
#pragma unroll
    for (int o = 32; o > 0; o >>= 1) v += __shfl_xor(v, o);
    return v;
}
__device__ __forceinline__ float wave_max(float v) {
#pragma unroll
    for (int o = 32; o > 0; o >>= 1) v = fmaxf(v, __shfl_xor(v, o));
    return v;
}
__device__ __forceinline__ float gelu_t(float x) { float u = 0.7978845608028654f * (x + 0.044715f * x * x * x); return x * __builtin_amdgcn_rcpf(1.f + __expf(-2.f * u)); }
__device__ __forceinline__ float sigmoidf_(float x) { return 1.f / (1.f + __expf(-x)); }

__device__ __forceinline__ int tid_op() { int t = threadIdx.x; asm volatile("" : "+v"(t)); return t; }

__device__ __forceinline__ void lds_barrier() { asm volatile("s_waitcnt lgkmcnt(0)\n\ts_barrier" ::: "memory"); }

__device__ __forceinline__ const float* in_row(const Params& p, int r) {
    int b = r / TB, j = r - b * TB;
    return (j < LC) ? p.ctx + ((size_t)b * LC + j) * D : p.x + ((size_t)b * SEQ + (j - LC)) * D;
}
__device__ __forceinline__ float* xs_row(const Params& p, int r) {
    int b = r / TB, j = r - b * TB;
    return (j < LC) ? (float*)(p.ws + WS_XC) + ((size_t)b * LC + j) * D : p.out + ((size_t)b * SEQ + (j - LC)) * D;
}
__device__ __forceinline__ int mod_idx(int r) { int b = r / TB, j = r - b * TB; return (j < LC) ? 4 : b; }

__device__ __forceinline__ void p0_mod(const Params& p, float* lds) {
    float* sv = lds;
    float* red = lds + 5 * 1024;
    const int tid = threadIdx.x, lane = tid & 63, wave = tid >> 6;
    for (int i = tid; i < 5 * 1024; i += 256) {
        int bi = i >> 10, k = i & 1023;
        float v = (bi < 4) ? p.c[bi * 1024 + k] : p.c_ctx[k];
        sv[i] = v / (1.f + __expf(-v));
    }
    __syncthreads();
    float* modv = (float*)(p.ws + WS_MOD);
    for (int it = blockIdx.x; it < 2 * 96; it += gridDim.x) {
        int l = it / 96, col = (it % 96) * 64 + lane;
        const float* w = p.w_mod + (size_t)l * D * 6144 + col;
        float a0 = 0, a1 = 0, a2 = 0, a3 = 0, a4 = 0;
        int k0 = wave * 256;
#pragma unroll 8
        for (int k = k0; k < k0 + 256; ++k) {
            float wv = w[(size_t)k * 6144];
            a0 += sv[k] * wv; a1 += sv[1024 + k] * wv; a2 += sv[2048 + k] * wv; a3 += sv[3072 + k] * wv; a4 += sv[4096 + k] * wv;
        }
        red[(wave * 5 + 0) * 64 + lane] = a0; red[(wave * 5 + 1) * 64 + lane] = a1; red[(wave * 5 + 2) * 64 + lane] = a2;
        red[(wave * 5 + 3) * 64 + lane] = a3; red[(wave * 5 + 4) * 64 + lane] = a4;
        __syncthreads();
        for (int i = tid; i < 320; i += 256) {
            int bi = i / 64, cl = i % 64;
            float s = red[(0 * 5 + bi) * 64 + cl] + red[(1 * 5 + bi) * 64 + cl] + red[(2 * 5 + bi) * 64 + cl] + red[(3 * 5 + bi) * 64 + cl];
            int cc = (it % 96) * 64 + cl;
            modv[((size_t)l * 5 + bi) * 6144 + cc] = s + p.b_mod[l * 6144 + cc];
        }
        __syncthreads();
    }
}
__device__ __forceinline__ void p0_transpose(const float* src, bf16* dst, int K, int N, int nmat, float* lds) {
    const int tid = threadIdx.x;
    const int tk = K / 64, tn = N / 64, per = tk * tn;
    for (int it = blockIdx.x; it < nmat * per; it += gridDim.x) {
        int mat = it / per, t = it % per, k0 = (t / tn) * 64, n0 = (t % tn) * 64;
        const float* s = src + (size_t)mat * K * N;
        bf16* d = dst + (size_t)mat * K * N;
        for (int i = tid; i < 4096; i += 256) { int kk = i >> 6, nn = i & 63; lds[kk * 65 + nn] = s[(size_t)(k0 + kk) * N + n0 + nn]; }
        __syncthreads();
        for (int i = tid; i < 4096; i += 256) { int nn = i >> 6, kk = i & 63; d[(size_t)(n0 + nn) * K + k0 + kk] = f2bf(lds[kk * 65 + nn]); }
        __syncthreads();
    }
}
__device__ __forceinline__ void p0_convert(const float* src, bf16* dst, size_t n) {
    size_t i = ((size_t)blockIdx.x * 256 + threadIdx.x) * 4, st = (size_t)gridDim.x * 256 * 4;
    for (; i < n; i += st) {
        float4 v = *(const float4*)(src + i);
        uint2 o; o.x = pk2(v.x, v.y); o.y = pk2(v.z, v.w);
        *(uint2*)(dst + i) = o;
    }
}

typedef float f2v __attribute__((ext_vector_type(2)));
__device__ __forceinline__ void p0_convert_fp8(const float* src, unsigned char* dst, float* scales, int nrows) {
    const int tidx = tid_op(), lane = tidx & 63, gw = blockIdx.x * 4 + __builtin_amdgcn_readfirstlane(tidx >> 6), nw = gridDim.x * 4;
    for (int r = gw; r < nrows; r += nw) {
        const float* row = src + (size_t)r * D + lane * 16;
        float v[16];
#pragma unroll
        for (int i = 0; i < 4; ++i) { float4 t = *(const float4*)(row + i * 4); v[i * 4] = t.x; v[i * 4 + 1] = t.y; v[i * 4 + 2] = t.z; v[i * 4 + 3] = t.w; }
        float am = 0.f;
#pragma unroll
        for (int i = 0; i < 16; ++i) am = fmaxf(am, fabsf(v[i]));
        am = wave_max(am);
        const float inv = (am > 0.f) ? 448.f / am : 1.f;
        u4v w;
#pragma unroll
        for (int i = 0; i < 4; ++i) {
            int t = 0;
            t = __builtin_amdgcn_cvt_pk_fp8_f32(v[i * 4] * inv, v[i * 4 + 1] * inv, t, false);
            t = __builtin_amdgcn_cvt_pk_fp8_f32(v[i * 4 + 2] * inv, v[i * 4 + 3] * inv, t, true);
            w[i] = (unsigned)t;
        }
        *(u4v*)(dst + (size_t)r * D + lane * 16) = w;
        if (lane == 0) scales[r] = (am > 0.f) ? am * (1.f / 448.f) : 1.f;
    }
}
__device__ __forceinline__ void phase0(const Params& p, float* lds) {
    p0_mod(p, lds);
    __syncthreads();
    p0_transpose(p.w_in, (bf16*)(p.ws + WS_WIN), D, DIN, 2, lds);
    p0_transpose(p.w_out, (bf16*)(p.ws + WS_WOUT), D, D, 2, lds);
    p0_transpose(p.peer_wq, (bf16*)(p.ws + WS_WQ), D, 2048, 2, lds);
    for (int g = 0; g < 2; ++g) {
        const float* src = g ? p.lru_wx : p.lru_wa;
        for (int ld = 0; ld < 4; ++ld)
            p0_transpose(src + (size_t)ld * 4 * 4096, (bf16*)(p.ws + WS_LRUW) + ((size_t)(ld * 2 + g) * 4) * 4096, 64, 64, 4, lds);
    }
    p0_convert(p.peer_keys, (bf16*)(p.ws + WS_KEYS), (size_t)2 * 2 * 128 * 128);
    p0_convert_fp8(p.peer_u, p.ws + WS_U, (float*)(p.ws + WS_US), 2 * NE);
    p0_convert_fp8(p.peer_v, p.ws + WS_V, (float*)(p.ws + WS_VS), 2 * NE);
    if (blockIdx.x == gridDim.x - 1) {
        float2* rt = (float2*)(p.ws + WS_ROPE);
        for (int i = threadIdx.x; i < 128 * 16; i += 256) {
            int pos = i >> 4, f = i & 15;
            float inv = powf(10000.f, -(float)f / 16.f);
            float ang = (float)pos * inv;
            rt[i] = make_float2(cosf(ang), sinf(ang));
        }
    }
}

__device__ __forceinline__ void modnorm_store(const float (&v)[16], const float* g, const float* sc, const float* sh, bf16* hrow, int lane) {
    float ss = 0;
#pragma unroll
    for (int i = 0; i < 16; ++i) ss += v[i] * v[i];
    ss = wave_sum(ss);
    float rstd = rsqrtf(ss * (1.f / 1024.f) + EPS);
#pragma unroll
    for (int hh = 0; hh < 2; ++hh) {
        int e0 = hh * 512 + lane * 8;
        float o[8];
#pragma unroll
        for (int i = 0; i < 8; ++i) o[i] = v[hh * 8 + i] * rstd * g[e0 + i] * (1.f + sc[e0 + i]) + sh[e0 + i];
        uint4 w; w.x = pk2(o[0], o[1]); w.y = pk2(o[2], o[3]); w.z = pk2(o[4], o[5]); w.w = pk2(o[6], o[7]);
        *(uint4*)(hrow + e0) = w;
    }
}
__device__ __forceinline__ void load_row16(const float* row, float (&v)[16], int lane) {
    float4 a = *(const float4*)(row + lane * 8), b = *(const float4*)(row + lane * 8 + 4);
    float4 c = *(const float4*)(row + 512 + lane * 8), d = *(const float4*)(row + 512 + lane * 8 + 4);
    v[0] = a.x; v[1] = a.y; v[2] = a.z; v[3] = a.w; v[4] = b.x; v[5] = b.y; v[6] = b.z; v[7] = b.w;
    v[8] = c.x; v[9] = c.y; v[10] = c.z; v[11] = c.w; v[12] = d.x; v[13] = d.y; v[14] = d.z; v[15] = d.w;
}
__device__ __forceinline__ void phase_rownorm(const Params& p, int l, int which) {
    const int tidx = tid_op(), lane = tidx & 63, gw = blockIdx.x * 4 + __builtin_amdgcn_readfirstlane(tidx >> 6), nw = gridDim.x * 4;
    const float* modv = (const float*)(p.ws + WS_MOD);
    bf16* H = (bf16*)(p.ws + WS_H);
    const int rpw = (M + nw - 1) / nw;
    const float* g = (which ? p.norm_ffn : p.norm_mix) + l * D;
    int cur_mi = -1;
    float gs[16], shv[16];
    for (int r = gw * rpw; r < (gw + 1) * rpw && r < M; ++r) {
        const int mi = mod_idx(r);
        if (l == 1 && which == 1 && mi == 4) continue;
        if (mi != cur_mi) {
            cur_mi = mi;
            const float* mv = modv + ((size_t)l * 5 + mi) * 6144;
            const float* sc = mv + (which ? 4096 : 1024); const float* sh = mv + (which ? 3072 : 0);
#pragma unroll
            for (int hh = 0; hh < 2; ++hh)
#pragma unroll
                for (int i = 0; i < 8; ++i) { const int e0 = hh * 512 + lane * 8 + i; gs[hh * 8 + i] = g[e0] * (1.f + sc[e0]); shv[hh * 8 + i] = sh[e0]; }
        }
        float v[16];
        load_row16(which ? xs_row(p, r) : in_row(p, r), v, lane);
        float ss = 0.f;
#pragma unroll
        for (int i = 0; i < 16; ++i) ss += v[i] * v[i];
        ss = wave_sum(ss);
        const float rstd = rsqrtf(ss * (1.f / 1024.f) + EPS);
        bf16* hrow = H + (size_t)r * D;
#pragma unroll
        for (int hh = 0; hh < 2; ++hh) {
            u4v w;
#pragma unroll
            for (int i = 0; i < 4; ++i) w[i] = pk2(v[hh * 8 + 2 * i] * rstd * gs[hh * 8 + 2 * i] + shv[hh * 8 + 2 * i], v[hh * 8 + 2 * i + 1] * rstd * gs[hh * 8 + 2 * i + 1] + shv[hh * 8 + 2 * i + 1]);
            *(u4v*)(hrow + hh * 512 + lane * 8) = w;
        }
    }
}

typedef short s8v __attribute__((ext_vector_type(8)));
typedef float f4v __attribute__((ext_vector_type(4)));
#define MFMA16(a, b, c) __builtin_amdgcn_mfma_f32_16x16x32_bf16((a), (b), (c), 0, 0, 0)
constexpr int GP = 72;
constexpr int TLDS = 128 * GP;
constexpr int SMEM_BYTES = 4 * TLDS * 2;

template <bool SWAP>
__device__ __forceinline__ void gemm_mainloop(const bf16* __restrict__ A, const bf16* __restrict__ Bt, bf16* lds, f4v (&acc)[4][4]) {
    const int tid = tid_op(), lane = tid & 63, wave = tid >> 6, wm = wave >> 1, wn = wave & 1;
    const int lrow = tid >> 3, lkc = tid & 7;
    const bf16* ag = A + (size_t)lrow * D + lkc * 8;
    const bf16* bg = Bt + (size_t)lrow * D + lkc * 8;
    bf16* sa = lds + lrow * GP + lkc * 8;
    u4v ra[4], rb[4];
#pragma unroll
    for (int i = 0; i < 4; ++i) { ra[i] = *(const u4v*)(ag + (size_t)i * 32 * D); rb[i] = *(const u4v*)(bg + (size_t)i * 32 * D); }
#pragma unroll
    for (int i = 0; i < 4; ++i) { *(u4v*)(sa + i * 32 * GP) = ra[i]; *(u4v*)(sa + TLDS + i * 32 * GP) = rb[i]; }
    __syncthreads();
    const int fro = (lane & 15) * GP + (lane >> 4) * 8;
#pragma unroll 1
    for (int kt = 0; kt < 16; ++kt) {
        const int buf = kt & 1;
        if (kt + 1 < 16) {
#pragma unroll
            for (int i = 0; i < 4; ++i) { ra[i] = *(const u4v*)(ag + (size_t)i * 32 * D + (kt + 1) * 64); rb[i] = *(const u4v*)(bg + (size_t)i * 32 * D + (kt + 1) * 64); }
        }
        const bf16* As = lds + buf * 2 * TLDS + wm * 64 * GP + fro;
        const bf16* Bs = lds + buf * 2 * TLDS + TLDS + wn * 64 * GP + fro;
#pragma unroll
        for (int ks = 0; ks < 2; ++ks) {
            s8v af[4], bfr[4];
#pragma unroll
            for (int i = 0; i < 4; ++i) { af[i] = *(const s8v*)(As + i * 16 * GP + ks * 32); bfr[i] = *(const s8v*)(Bs + i * 16 * GP + ks * 32); }
            __builtin_amdgcn_s_setprio(1);
#pragma unroll
            for (int mi = 0; mi < 4; ++mi)
#pragma unroll
                for (int nj = 0; nj < 4; ++nj)
                    acc[mi][nj] = SWAP ? MFMA16(bfr[nj], af[mi], acc[mi][nj]) : MFMA16(af[mi], bfr[nj], acc[mi][nj]);
            __builtin_amdgcn_s_setprio(0);
        }
        if (kt + 1 < 16) {
            bf16* sd = sa + (buf ^ 1) * 2 * TLDS;
#pragma unroll
            for (int i = 0; i < 4; ++i) { *(u4v*)(sd + i * 32 * GP) = ra[i]; *(u4v*)(sd + TLDS + i * 32 * GP) = rb[i]; }
        }
        __syncthreads();
    }
}

__device__ __forceinline__ void phase_inproj_fast(const Params& p, int l, bf16* lds) {
    const int tid = tid_op(), lane = tid & 63, wave = tid >> 6, wm = wave >> 1, wn = wave & 1, l15 = lane & 15, gq = lane >> 4;
    const bf16* H = (const bf16*)(p.ws + WS_H);
    const bf16* W = (const bf16*)(p.ws + WS_WIN) + (size_t)l * DIN * D;
    bf16* Z = (bf16*)(p.ws + WS_Z);
    const float2* rt = (const float2*)(p.ws + WS_ROPE);
    for (int tile = blockIdx.x; tile < 264 * 18; tile += gridDim.x) {
        const int mt = tile / 18, nt = tile - mt * 18;
        const bf16* A = H + (size_t)mt * 128 * D;
        const bf16* Bt = W + (size_t)nt * 128 * D;
        const int bb = mt / 66, jt = (mt - bb * 66) * 128;
        f4v acc[4][4];
#pragma unroll
        for (int i = 0; i < 4; ++i)
#pragma unroll
            for (int j = 0; j < 4; ++j) acc[i][j] = (f4v){0.f, 0.f, 0.f, 0.f};
        const int s = nt * 2 + wn;
        const bool isv = (nt == 3) || (nt == 7) || (nt == 12) || (nt == 13);
        if (isv) {
            gemm_mainloop<false>(A, Bt, lds, acc);
            int vkind, vh;
            if (s < 8) { vkind = 0; vh = s - 6; } else if (s < 16) { vkind = 1; vh = s - 14; } else { vkind = 2; vh = s - 24; }
            bf16* vt = (vkind == 0) ? (bf16*)(p.ws + WS_VTA) + ((size_t)(bb * 2 + vh) * 64) * TB
                     : (vkind == 1) ? (bf16*)(p.ws + WS_VTB) + ((size_t)(bb * 2 + vh) * 64) * TB
                                    : (bf16*)(p.ws + WS_VTN) + ((size_t)(bb * 4 + vh) * 64) * TB;
            bf16* stg = lds + wave * (64 * GP);
#pragma unroll
            for (int mi = 0; mi < 4; ++mi)
#pragma unroll
                for (int nj = 0; nj < 4; ++nj) {
                    uint2 w; w.x = pk2(acc[mi][nj][0], acc[mi][nj][1]); w.y = pk2(acc[mi][nj][2], acc[mi][nj][3]);
                    *(uint2*)(stg + (nj * 16 + l15) * GP + mi * 16 + gq * 4) = w;
                }
#pragma unroll
            for (int it = 0; it < 8; ++it) {
                const int rs = it * 8 + (lane >> 3), ch = lane & 7;
                *(u4v*)(vt + (size_t)rs * TB + jt + wm * 64 + ch * 8) = *(const u4v*)(stg + rs * GP + ch * 8);
            }
        } else {
            gemm_mainloop<true>(A, Bt, lds, acc);
            int zcol; bool nrm = false, rope = false, isq = false; const float* g = p.qn_g;
            if (s < 4) { zcol = ZQA + 64 * s; rope = true; isq = true; }
            else if (s < 6) { zcol = ZKA + 64 * (s - 4); rope = true; }
            else if (s < 12) { zcol = ZQB + 64 * (s - 8); rope = true; isq = true; nrm = true; g = p.qn_g + l * 64; }
            else if (s < 14) { zcol = ZKB + 64 * (s - 12); rope = true; nrm = true; g = p.kn_g + l * 64; }
            else if (s < 20) { zcol = ZQN + 64 * (s - 16); isq = true; }
            else if (s < 24) { zcol = ZKN + 64 * (s - 20); }
            else if (s < 32) { zcol = ZXR + 64 * (s - 28); }
            else { zcol = ZXG + 64 * (s - 32); }
            const bool latent = jt >= LC;
            bf16* stg = lds + wave * (64 * GP);
#pragma unroll
            for (int mi = 0; mi < 4; ++mi) {
                const int j = jt + wm * 64 + mi * 16 + l15;
                float v[4][4];
#pragma unroll
                for (int nj = 0; nj < 4; ++nj)
#pragma unroll
                    for (int q = 0; q < 4; ++q) v[nj][q] = acc[mi][nj][q];
                if (nrm) {
                    float ss = 0.f;
#pragma unroll
                    for (int nj = 0; nj < 4; ++nj)
#pragma unroll
                        for (int q = 0; q < 4; ++q) ss += v[nj][q] * v[nj][q];
                    ss += __shfl_xor(ss, 16); ss += __shfl_xor(ss, 32);
                    const float rstd = rsqrtf(ss * (1.f / 64.f) + EPS);
#pragma unroll
                    for (int nj = 0; nj < 4; ++nj) {
                        const float4 g4 = *(const float4*)(g + nj * 16 + gq * 4);
                        v[nj][0] *= rstd * g4.x; v[nj][1] *= rstd * g4.y; v[nj][2] *= rstd * g4.z; v[nj][3] *= rstd * g4.w;
                    }
                }
                if (rope && latent) {
                    const int t = j - LC, pr = t >> 6, pc = t & 63;
                    const float4* r1 = (const float4*)(rt + pr * 16 + gq * 4);
                    const float4* r2 = (const float4*)(rt + pc * 16 + gq * 4);
                    const float4 a0 = r1[0], a1 = r1[1], b0 = r2[0], b1 = r2[1];
                    const float cs1[4][2] = {{a0.x, a0.y}, {a0.z, a0.w}, {a1.x, a1.y}, {a1.z, a1.w}};
                    const float cs2[4][2] = {{b0.x, b0.y}, {b0.z, b0.w}, {b1.x, b1.y}, {b1.z, b1.w}};
#pragma unroll
                    for (int q = 0; q < 4; ++q) {
                        const float x1 = v[0][q], x2 = v[1][q], y1 = v[2][q], y2 = v[3][q];
                        v[0][q] = x1 * cs1[q][0] - x2 * cs1[q][1]; v[1][q] = x1 * cs1[q][1] + x2 * cs1[q][0];
                        v[2][q] = y1 * cs2[q][0] - y2 * cs2[q][1]; v[3][q] = y1 * cs2[q][1] + y2 * cs2[q][0];
                    }
                }
                const float sc = isq ? (nrm ? 0.125f * 1.4426950408889634f : 0.125f) : 1.f;
#pragma unroll
                for (int nj = 0; nj < 4; ++nj) {
                    uint2 w; w.x = pk2(v[nj][0] * sc, v[nj][1] * sc); w.y = pk2(v[nj][2] * sc, v[nj][3] * sc);
                    *(uint2*)(stg + (mi * 16 + l15) * GP + nj * 16 + gq * 4) = w;
                }
            }
            {
                const size_t r0 = (size_t)bb * TB + jt + wm * 64;
#pragma unroll
                for (int it = 0; it < 8; ++it) {
                    const int rs = it * 8 + (lane >> 3), ch = lane & 7;
                    *(u4v*)(Z + (r0 + rs) * ZP + zcol + ch * 8) = *(const u4v*)(stg + rs * GP + ch * 8);
                }
            }
        }
        __syncthreads();
    }
}

__device__ __forceinline__ void phase_outproj_fast(const Params& p, int l, bf16* lds) {
    const int tid = tid_op(), lane = tid & 63, wave = tid >> 6, wm = wave >> 1, wn = wave & 1, l15 = lane & 15, gq = lane >> 4;
    const bf16* Y = (const bf16*)(p.ws + WS_Y);
    const bf16* W = (const bf16*)(p.ws + WS_WOUT) + (size_t)l * D * D;
    const float* modv = (const float*)(p.ws + WS_MOD);
    for (int tile = blockIdx.x; tile < 264 * 8; tile += gridDim.x) {
        const int mt = tile >> 3, nt = tile & 7;
        const int bb = mt / 66, jt = (mt - bb * 66) * 128;
        if (l == 1 && jt < LC) continue;
        f4v acc[4][4];
#pragma unroll
        for (int i = 0; i < 4; ++i)
#pragma unroll
            for (int j = 0; j < 4; ++j) acc[i][j] = (f4v){0.f, 0.f, 0.f, 0.f};
        gemm_mainloop<true>(Y + (size_t)mt * 128 * D, W + (size_t)nt * 128 * D, lds, acc);
        const float* gtv = modv + ((size_t)l * 5 + (jt < LC ? 4 : bb)) * 6144 + 2048;
        float* stg = (float*)lds + wave * (64 * 68);
#pragma unroll
        for (int mi = 0; mi < 4; ++mi)
#pragma unroll
            for (int nj = 0; nj < 4; ++nj) *(f4v*)(stg + (mi * 16 + l15) * 68 + nj * 16 + gq * 4) = acc[mi][nj];
        {
            const int c4 = (lane & 15) * 4, col = nt * 128 + wn * 64 + c4;
            const float4 gt = *(const float4*)(gtv + col);
#pragma unroll 4
            for (int it = 0; it < 16; ++it) {
                const int rs = it * 4 + (lane >> 4);
                const int r = bb * TB + jt + wm * 64 + rs;
                const float* xin = (l == 0) ? in_row(p, r) : xs_row(p, r);
                float* xo = xs_row(p, r);
                const f4v a = *(const f4v*)(stg + rs * 68 + c4);
                const float4 xi = *(const float4*)(xin + col);
                *(float4*)(xo + col) = make_float4(xi.x + gt.x * a[0], xi.y + gt.y * a[1], xi.z + gt.z * a[2], xi.w + gt.w * a[3]);
            }
        }
        __syncthreads();
    }
}

__device__ __forceinline__ void ce_desc(unsigned& a, unsigned& b) { const unsigned hi = max(a, b), lo = min(a, b); a = hi; b = lo; }
__device__ __forceinline__ void bitonic_merge16(unsigned (&v)[16]) {
#pragma unroll
    for (int j = 8; j > 0; j >>= 1)
#pragma unroll
        for (int i = 0; i < 16; ++i) { const int l = i ^ j; if (l > i) ce_desc(v[i], v[l]); }
}
__device__ __forceinline__ void bitonic_sort16(unsigned (&v)[16]) {
#pragma unroll
    for (int k = 2; k <= 16; k <<= 1)
#pragma unroll
        for (int j = k >> 1; j > 0; j >>= 1)
#pragma unroll
            for (int i = 0; i < 16; ++i) {
                const int l = i ^ j;
                if (l > i) { if ((i & k) == 0 || k == 16) ce_desc(v[i], v[l]); else ce_desc(v[l], v[i]); }
            }
}
__device__ __forceinline__ unsigned f2ord(float f) { unsigned u = __float_as_uint(f); return (u & 0x80000000u) ? ~u : (u | 0x80000000u); }
__device__ __forceinline__ void phase_peerq_fast(const Params& p, int l, bf16* lds) {
    const int tid = tid_op(), lane = tid & 63, wave = tid >> 6, wm = wave >> 1, wn = wave & 1, l15 = lane & 15, gq = lane >> 4;
    const bf16* H = (const bf16*)(p.ws + WS_H);
    const bf16* W = (const bf16*)(p.ws + WS_WQ) + (size_t)l * 2048 * D;
    const bf16* KY = (const bf16*)(p.ws + WS_KEYS) + (size_t)l * 2 * 128 * 128;
    float* stop = (float*)(p.ws + WS_STOP);
    unsigned char* itop = p.ws + WS_ITOP;
    constexpr int QP = 136, SP = 132;
    bf16* Qs = lds; bf16* Ks = lds + 128 * QP;
    float* Sf = (float*)lds;
    for (int tile = blockIdx.x; tile < 264 * 16; tile += gridDim.x) {
        const int mt = tile >> 4, hp = tile & 15;
        const int bb = mt / 66, jt = (mt - bb * 66) * 128;
        if (l == 1 && jt < LC) continue;
        f4v acc[4][4];
#pragma unroll
        for (int i = 0; i < 4; ++i)
#pragma unroll
            for (int j = 0; j < 4; ++j) acc[i][j] = (f4v){0.f, 0.f, 0.f, 0.f};
        u4v kreg[8];
        {
            const bf16* kg = KY + (size_t)(hp & 1) * 128 * 128;
#pragma unroll
            for (int i = 0; i < 8; ++i) { int c = tid + i * 256, row = c >> 4, kc = c & 15; kreg[i] = *(const u4v*)(kg + row * 128 + kc * 8); }
        }
        gemm_mainloop<true>(H + (size_t)mt * 128 * D, W + (size_t)hp * 128 * D, lds, acc);
#pragma unroll
        for (int mi = 0; mi < 4; ++mi)
#pragma unroll
            for (int nj = 0; nj < 4; ++nj) {
                uint2 w; w.x = pk2(acc[mi][nj][0], acc[mi][nj][1]); w.y = pk2(acc[mi][nj][2], acc[mi][nj][3]);
                *(uint2*)(Qs + (wm * 64 + mi * 16 + l15) * QP + wn * 64 + nj * 16 + gq * 4) = w;
            }
#pragma unroll
        for (int i = 0; i < 8; ++i) { int c = tid + i * 256, row = c >> 4, kc = c & 15; *(u4v*)(Ks + row * QP + kc * 8) = kreg[i]; }
        __syncthreads();
        f4v a2[2][8];
#pragma unroll
        for (int i = 0; i < 2; ++i)
#pragma unroll
            for (int j = 0; j < 8; ++j) a2[i][j] = (f4v){0.f, 0.f, 0.f, 0.f};
#pragma unroll
        for (int ks = 0; ks < 4; ++ks) {
            s8v af[2], bfr[8];
#pragma unroll
            for (int i = 0; i < 2; ++i) af[i] = *(const s8v*)(Qs + (wave * 32 + i * 16 + l15) * QP + ks * 32 + gq * 8);
#pragma unroll
            for (int j = 0; j < 8; ++j) bfr[j] = *(const s8v*)(Ks + (j * 16 + l15) * QP + ks * 32 + gq * 8);
            __builtin_amdgcn_s_setprio(1);
#pragma unroll
            for (int i = 0; i < 2; ++i)
#pragma unroll
                for (int j = 0; j < 8; ++j) a2[i][j] = MFMA16(bfr[j], af[i], a2[i][j]);
            __builtin_amdgcn_s_setprio(0);
        }
        __syncthreads();
#pragma unroll
        for (int i = 0; i < 2; ++i)
#pragma unroll
            for (int j = 0; j < 8; ++j) *(f4v*)(Sf + (wave * 32 + i * 16 + l15) * SP + j * 16 + gq * 4) = a2[i][j];
        __syncthreads();
        {
            const int row = tid >> 1, half = tid & 1;
            const float* sr = Sf + row * SP;
            unsigned L[16];
#pragma unroll
            for (int ch = 0; ch < 4; ++ch) {
                unsigned C[16];
#pragma unroll
                for (int i4 = 0; i4 < 4; ++i4) {
                    const int col = half * 64 + ch * 16 + i4 * 4;
                    const f4v s4 = *(const f4v*)(sr + col);
#pragma unroll
                    for (int q = 0; q < 4; ++q) C[i4 * 4 + q] = (f2ord(s4[q]) & ~127u) | (unsigned)(col + q);
                }
                bitonic_sort16(C);
                if (ch == 0) {
#pragma unroll
                    for (int i = 0; i < 16; ++i) L[i] = C[i];
                } else {
#pragma unroll
                    for (int i = 0; i < 16; ++i) L[i] = max(L[i], C[15 - i]);
                    bitonic_merge16(L);
                }
            }
            {
                unsigned Pn[16];
#pragma unroll
                for (int i = 0; i < 16; ++i) Pn[i] = __shfl_xor(L[i], 1);
#pragma unroll
                for (int i = 0; i < 16; ++i) L[i] = max(L[i], Pn[15 - i]);
                bitonic_merge16(L);
            }
            if (half == 0) {
                const size_t r = (size_t)bb * TB + jt + row;
                float sv[16];
#pragma unroll
                for (int i = 0; i < 16; ++i) sv[i] = sr[L[i] & 127u];
                float* so = stop + (r * 16 + hp) * 16;
#pragma unroll
                for (int i = 0; i < 4; ++i) *(float4*)(so + i * 4) = make_float4(sv[i * 4], sv[i * 4 + 1], sv[i * 4 + 2], sv[i * 4 + 3]);
                u4v iw;
#pragma unroll
                for (int i = 0; i < 4; ++i) iw[i] = (L[i * 4] & 127u) | ((L[i * 4 + 1] & 127u) << 8) | ((L[i * 4 + 2] & 127u) << 16) | ((L[i * 4 + 3] & 127u) << 24);
                *(u4v*)(itop + (r * 16 + hp) * 16) = iw;
            }
        }
        __syncthreads();
    }
}


__device__ __forceinline__ unsigned cvtpk(float lo, float hi) { f32x2_t v = {lo, hi}; return __builtin_bit_cast(unsigned, __builtin_convertvector(v, bf16x2_t)); }
__device__ __forceinline__ float max3f(float a, float b, float c) { float r; asm("v_max3_f32 %0, %1, %2, %3" : "=v"(r) : "v"(a), "v"(b), "v"(c)); return r; }
constexpr int ATL = 64 * GP;
constexpr int BIAS_OFF_B = 66048, LRUW_OFF_B = 49152;

template <int KIND>
__device__ __forceinline__ void attn_item_fast(const Params& p, int l, int b, int hsel, int blk, bool ctxq, bf16* lds, const float* biasLds) {
    constexpr int kind = KIND;
    const int tid = tid_op(), lane = tid & 63, wave = __builtin_amdgcn_readfirstlane(tid >> 6), l15 = lane & 15, gq = lane >> 4;
    const bf16* Z = (const bf16*)(p.ws + WS_Z) + (size_t)b * TB * ZP;
    int head, j0;
    if (kind == 2) { head = hsel; j0 = ctxq ? wave * 64 : LC + (blk * 4 + wave) * 64; }
    else { head = hsel * 2 + (wave >> 1); j0 = (ctxq ? 0 : LC) + blk * 128 + (wave & 1) * 64; }
    const int kvh = (kind == 2) ? head : hsel;
    const int qcol = (kind == 0 ? ZQA : kind == 1 ? ZQB : ZQN) + head * 64;
    const int kcol = (kind == 0 ? ZKA : kind == 1 ? ZKB : ZKN) + kvh * 64;
    const bf16* Vg = (kind == 0) ? (const bf16*)(p.ws + WS_VTA) + ((size_t)(b * 2 + kvh) * 64) * TB
                   : (kind == 1) ? (const bf16*)(p.ws + WS_VTB) + ((size_t)(b * 2 + kvh) * 64) * TB
                                 : (const bf16*)(p.ws + WS_VTN) + ((size_t)(b * 4 + kvh) * 64) * TB;
    const bf16* Kg = Z + kcol;
    s8v qf[4][2];
#pragma unroll
    for (int nt = 0; nt < 4; ++nt)
#pragma unroll
        for (int ks = 0; ks < 2; ++ks) qf[nt][ks] = *(const s8v*)(Z + (size_t)(j0 + nt * 16 + l15) * ZP + qcol + ks * 32 + gq * 8);
#pragma unroll
    for (int nt = 0; nt < 4; ++nt)
#pragma unroll
        for (int ks = 0; ks < 2; ++ks) asm volatile("" : "+v"(qf[nt][ks]));
    int ntile = 4, locbase = 0;
    if (!ctxq) {
        if (kind == 1) { ntile = 132; }
        else if (kind == 0) { int lo = (blk - 1) * 128, hi = (blk + 2) * 128; lo = lo < 0 ? 0 : lo; hi = hi > SEQ ? SEQ : hi; ntile = 4 + ((hi - lo) >> 6); locbase = LC + lo; }
        else { int lo = blk * 4 - 4; lo = lo < 0 ? 0 : (lo > 120 ? 120 : lo); int hi = blk * 4 + 3 - 4; hi = hi < 0 ? 0 : (hi > 120 ? 120 : hi); hi += 7; ntile = 4 + (hi - lo + 1); locbase = LC + lo * 64; }
    }
    const int qt0 = j0 - LC;
    int kr0w = (qt0 >> 6) - 4; kr0w = kr0w < 0 ? 0 : (kr0w > 120 ? 120 : kr0w);
    f4v ot[4][4];
    float mrun[4], ls[4];
#pragma unroll
    for (int i = 0; i < 4; ++i) {
        mrun[i] = -1e30f; ls[i] = 0.f;
#pragma unroll
        for (int j = 0; j < 4; ++j) ot[i][j] = (f4v){0.f, 0.f, 0.f, 0.f};
    }
    float negc = 0.f;
    if (KIND == 1) {
        const float gqm = wave_max(fabsf(p.qn_g[l * 64 + lane])), gkm = wave_max(fabsf(p.kn_g[l * 64 + lane]));
        negc = -8.f * gqm * gkm * 1.0002f * 1.4426950408889634f;
    }
    const int lr = tid >> 3, lc = tid & 7;
    const int vpos = (lc >> 2) * 32 + (lc & 1) * 16 + ((lc >> 1) & 1) * 4;
    u4v rk[2], rv[2];
    {
        const int kb0 = 0;
#pragma unroll
        for (int c = 0; c < 2; ++c) {
            rk[c] = *(const u4v*)(Kg + (size_t)(kb0 + lr + 32 * c) * ZP + lc * 8);
            rv[c] = *(const u4v*)(Vg + (size_t)(lr + 32 * c) * TB + kb0 + lc * 8);
        }
#pragma unroll
        for (int c = 0; c < 2; ++c) {
            *(u4v*)(lds + (lr + 32 * c) * GP + lc * 8) = rk[c];
            bf16* vd = lds + ATL + (lr + 32 * c) * GP + vpos;
            *(uint2*)vd = make_uint2(rv[c][0], rv[c][1]); *(uint2*)(vd + 8) = make_uint2(rv[c][2], rv[c][3]);
        }
    }
    __syncthreads();
#pragma unroll 1
    for (int i = 0; i < ntile; ++i) {
        const int buf = i & 1;
        if (i + 1 < ntile) {
            const int kb1 = (kind == 1 || ctxq || i + 1 < 4) ? (i + 1) * 64 : locbase + (i + 1 - 4) * 64;
#pragma unroll
            for (int c = 0; c < 2; ++c) {
                rk[c] = *(const u4v*)(Kg + (size_t)(kb1 + lr + 32 * c) * ZP + lc * 8);
                rv[c] = *(const u4v*)(Vg + (size_t)(lr + 32 * c) * TB + kb1 + lc * 8);
            }
        }
        bool use = true; int maskmode = 0; int tt0 = 0, krow = 0;
        if (!ctxq && i >= 4) {
            if (kind == 0) { tt0 = locbase - LC + (i - 4) * 64; use = (tt0 + 63 >= qt0 - 128) && (tt0 <= qt0 + 63 + 128); maskmode = 1; }
            else if (kind == 2) { krow = ((locbase - LC) >> 6) + (i - 4); use = (krow >= kr0w) && (krow < kr0w + 8); maskmode = 2; }
        }
        if (use) {
            const bf16* Ks = lds + buf * 2 * ATL;
            const bf16* Vs = Ks + ATL;
            const float* bt = biasLds + head * 465 + (krow - (qt0 >> 6) + 7) * 31 + 15;
#pragma unroll 1
            for (int hk = 0; hk < 2; ++hk) {
                f4v st[2][4];
#pragma unroll
                for (int a = 0; a < 2; ++a)
#pragma unroll
                    for (int c = 0; c < 4; ++c) st[a][c] = (f4v){negc, negc, negc, negc};
#pragma unroll
                for (int ks = 0; ks < 2; ++ks) {
                    s8v kf[2];
#pragma unroll
                    for (int mt = 0; mt < 2; ++mt) kf[mt] = *(const s8v*)(Ks + ((hk * 2 + mt) * 16 + l15) * GP + ks * 32 + gq * 8);
                    __builtin_amdgcn_s_setprio(1);
#pragma unroll
                    for (int mt = 0; mt < 2; ++mt)
#pragma unroll
                        for (int nt = 0; nt < 4; ++nt) st[mt][nt] = MFMA16(kf[mt], qf[nt][ks], st[mt][nt]);
                    __builtin_amdgcn_s_setprio(0);
                }
                if (maskmode == 1) {
#pragma unroll
                    for (int nt = 0; nt < 4; ++nt) {
                        const int qt = qt0 + nt * 16 + l15;
#pragma unroll
                        for (int mt = 0; mt < 2; ++mt)
#pragma unroll
                            for (int q = 0; q < 4; ++q) { int dl = tt0 + (hk * 2 + mt) * 16 + gq * 4 + q - qt; if (dl > 128 || dl < -128) st[mt][nt][q] = -1e30f; }
                    }
                } else if (maskmode == 2) {
#pragma unroll
                    for (int nt = 0; nt < 4; ++nt) {
                        const int qc = nt * 16 + l15;
                        int cs0 = qc - 8; cs0 = cs0 < 0 ? 0 : (cs0 > 48 ? 48 : cs0);
#pragma unroll
                        for (int mt = 0; mt < 2; ++mt)
#pragma unroll
                            for (int q = 0; q < 4; ++q) {
                                const int kc = (hk * 2 + mt) * 16 + gq * 4 + q;
                                int dc = kc - qc; dc = dc < -15 ? -15 : (dc > 15 ? 15 : dc);
                                const bool ok = (kc >= cs0) && (kc < cs0 + 16);
                                st[mt][nt][q] = ok ? st[mt][nt][q] + bt[dc] : -1e30f;
                            }
                    }
                }
                s8v pf[4];
#pragma unroll
                for (int nt = 0; nt < 4; ++nt) {
                    float psum = 0.f;
                    if (KIND == 1) {
#pragma unroll
                        for (int mt = 0; mt < 2; ++mt)
#pragma unroll
                            for (int q = 0; q < 4; ++q) { float pv = __builtin_amdgcn_exp2f(st[mt][nt][q]); st[mt][nt][q] = pv; psum += pv; }
                    } else {
                        float mx = max3f(max3f(st[0][nt][0], st[0][nt][1], st[0][nt][2]), max3f(st[0][nt][3], st[1][nt][0], st[1][nt][1]), max3f(st[1][nt][2], st[1][nt][3], mrun[nt]));
                        mx = max3f(mx, __shfl_xor(mx, 16), mx); mx = max3f(mx, __shfl_xor(mx, 32), mx);
                        if (__any(mx > mrun[nt] + 8.f)) {
                            const float mnew = fmaxf(mrun[nt], mx);
                            const float alpha = __expf(mrun[nt] - mnew);
                            mrun[nt] = mnew;
                            ls[nt] *= alpha;
#pragma unroll
                            for (int dt = 0; dt < 4; ++dt) ot[dt][nt] *= alpha;
                        }
                        const float mcur = mrun[nt];
#pragma unroll
                        for (int mt = 0; mt < 2; ++mt)
#pragma unroll
                            for (int q = 0; q < 4; ++q) { float pv = __expf(st[mt][nt][q] - mcur); st[mt][nt][q] = pv; psum += pv; }
                    }
                    ls[nt] += psum;
                    u4v w;
                    w[0] = cvtpk(st[0][nt][0], st[0][nt][1]); w[1] = cvtpk(st[0][nt][2], st[0][nt][3]);
                    w[2] = cvtpk(st[1][nt][0], st[1][nt][1]); w[3] = cvtpk(st[1][nt][2], st[1][nt][3]);
                    pf[nt] = __builtin_bit_cast(s8v, w);
                }
                s8v vf[4];
#pragma unroll
                for (int dt = 0; dt < 4; ++dt) {
                    vf[dt] = *(const s8v*)(Vs + (dt * 16 + l15) * GP + hk * 32 + gq * 8);
                }
                __builtin_amdgcn_s_setprio(1);
#pragma unroll
                for (int dt = 0; dt < 4; ++dt)
#pragma unroll
                    for (int nt = 0; nt < 4; ++nt) ot[dt][nt] = MFMA16(vf[dt], pf[nt], ot[dt][nt]);
                __builtin_amdgcn_s_setprio(0);
            }
        }
        if (i + 1 < ntile) {
            bf16* kd = lds + (buf ^ 1) * 2 * ATL;
#pragma unroll
            for (int c = 0; c < 2; ++c) {
                *(u4v*)(kd + (lr + 32 * c) * GP + lc * 8) = rk[c];
                bf16* vd = kd + ATL + (lr + 32 * c) * GP + vpos;
                *(uint2*)vd = make_uint2(rv[c][0], rv[c][1]); *(uint2*)(vd + 8) = make_uint2(rv[c][2], rv[c][3]);
            }
        }
        __syncthreads();
    }
    const float sk = (kind == 0) ? p.attn_sink[l * 4 + head] : 0.f;
#pragma unroll
    for (int nt = 0; nt < 4; ++nt) {
        float lsum = ls[nt];
        lsum += __shfl_xor(lsum, 16); lsum += __shfl_xor(lsum, 32);
        float scale = 1.f;
        if (kind == 0) { const float mx = fmaxf(mrun[nt], sk), a = __expf(mrun[nt] - mx); lsum = lsum * a + __expf(sk - mx); scale = a; }
        const float inv = scale / lsum;
        bf16* y = (bf16*)(p.ws + WS_Y) + ((size_t)b * TB + j0 + nt * 16 + l15) * D + kind * 256 + head * 64;
#pragma unroll
        for (int dt = 0; dt < 4; ++dt) {
            uint2 w; w.x = cvtpk(ot[dt][nt][0] * inv, ot[dt][nt][1] * inv); w.y = cvtpk(ot[dt][nt][2] * inv, ot[dt][nt][3] * inv);
            *(uint2*)(y + dt * 16 + gq * 4) = w;
        }
    }
}


constexpr int LX_OFF = 0, LU_OFF = 8704, LA_OFF = 17920, LB_OFF = 34304, LCW_OFF = 50688, LWX_OFF = 51968;
template <int STP>
__device__ __forceinline__ void seg_aggr(const float* Aa, const float* Bb, int a0, float& ap, float& hl) {
#pragma unroll
    for (int half = 0; half < 2; ++half) {
        float av[8], bv[8];
#pragma unroll
        for (int i = 0; i < 8; ++i) { av[i] = Aa[a0 + (half * 8 + i) * STP]; bv[i] = Bb[a0 + (half * 8 + i) * STP]; }
#pragma unroll
        for (int i = 0; i < 8; ++i) { hl = av[i] * hl + bv[i]; ap *= av[i]; }
    }
}
template <int STP>
__device__ __forceinline__ void seg_apply(float* Aa, float* Bb, int a0, float hin, float ain) {
#pragma unroll
    for (int half = 0; half < 2; ++half) {
        float av[8], bv[8];
#pragma unroll
        for (int i = 0; i < 8; ++i) { av[i] = Aa[a0 + (half * 8 + i) * STP]; bv[i] = Bb[a0 + (half * 8 + i) * STP]; }
#pragma unroll
        for (int i = 0; i < 8; ++i) { hin = av[i] * hin + bv[i]; ain *= av[i]; av[i] = hin; bv[i] = ain; }
#pragma unroll
        for (int i = 0; i < 8; ++i) { Aa[a0 + (half * 8 + i) * STP] = av[i]; Bb[a0 + (half * 8 + i) * STP] = bv[i]; }
    }
}
constexpr int LRU_NSEG = 6, LRU_SEGC = 22;
constexpr int LRU_ITEMS = 16 * 2 * LRU_NSEG;
__device__ __forceinline__ void lru_item_fast(const Params& p, int l, int b, int n, int dir, int seg, unsigned char* smem) {
    const int tid = tid_op(), lane = tid & 63, wave = __builtin_amdgcn_readfirstlane(tid >> 6), l15 = lane & 15, gq = lane >> 4;
    bf16* Xs = (bf16*)(smem + LX_OFF);
    bf16* Us = (bf16*)(smem + LU_OFF);
    float* Aa = (float*)(smem + LA_OFF);
    float* Bb = (float*)(smem + LB_OFF);
    float* CW = (float*)(smem + LCW_OFF);
    float* SAg = (float*)(smem + LWX_OFF + 9216);
    float* SBg = SAg + 256;
    bf16* WXs = (bf16*)(smem + LWX_OFF);
    const bf16* Z = (const bf16*)(p.ws + WS_Z) + (size_t)b * TB * ZP;
    float* HL = (float*)(p.ws + (dir ? WS_H : WS_HF)) + ((size_t)b * TB) * 256 + n * 64;
    float* AC = HL + (size_t)M * 256;
    for (int i = tid; i < 320; i += 256) { int q = i >> 6, c = i & 63; CW[i] = (q < 4) ? p.conv_w[(l * 4 + q) * 256 + n * 64 + c] : p.conv_b[l * 256 + n * 64 + c]; }
    const int ptok = tid >> 2, ppart = tid & 3;
    const int lr = tid >> 3, lc = tid & 7;
    const bf16* wbase = (const bf16*)(p.ws + WS_LRUW) + ((size_t)((l * 2 + dir) * 2) * 4 + n) * 4096;
    s8v wfa[4][2];
#pragma unroll
    for (int nj = 0; nj < 4; ++nj)
#pragma unroll
        for (int ks = 0; ks < 2; ++ks) wfa[nj][ks] = *(const s8v*)(wbase + (nj * 16 + l15) * 64 + ks * 32 + gq * 8);
#pragma unroll
    for (int i = 0; i < 2; ++i) { int cidx = tid + i * 256, row = cidx >> 3, kc = cidx & 7; *(u4v*)(WXs + row * GP + kc * 8) = *(const u4v*)(wbase + (size_t)4 * 4096 + row * 64 + kc * 8); }
    float cba[4], cbx[4], csp[4];
#pragma unroll
    for (int nj = 0; nj < 4; ++nj) {
        const int ch = n * 64 + nj * 16 + l15;
        cba[nj] = p.lru_ba[(l * 2 + dir) * 256 + ch]; cbx[nj] = p.lru_bx[(l * 2 + dir) * 256 + ch];
        const float lam = p.lru_lam[(l * 2 + dir) * 256 + ch];
        csp[nj] = (lam > 15.f) ? __expf(-lam) : log1pf(__expf(-lam));
    }
#pragma unroll
    for (int nj = 0; nj < 4; ++nj) {
#pragma unroll
        for (int ks = 0; ks < 2; ++ks) asm volatile("" : "+v"(wfa[nj][ks]));
        asm volatile("" : "+v"(cba[nj]), "+v"(cbx[nj]), "+v"(csp[nj]));
    }
    float h = 0.f, ain = 1.f;
    u4v rx[3];
    const int cbeg = seg * LRU_SEGC;
    {
        const int c = cbeg;
        const int jlo = dir ? (c < 4 ? LC - 64 - c * 64 : TB + LC - 64 - c * 64) : c * 64;
        const int lo = (jlo < LC) ? 0 : LC, hi = (jlo < LC) ? LC : TB;
#pragma unroll
        for (int i = 0; i < 3; ++i) { int row = lr + 32 * i, jj = jlo - 2 + row; rx[i] = (row < 67 && jj >= lo && jj < hi) ? *(const u4v*)(Z + (size_t)jj * ZP + ZXR + n * 64 + lc * 8) : (u4v){0u, 0u, 0u, 0u}; }
#pragma unroll
        for (int i = 0; i < 3; ++i) if (lr + 32 * i < 68) *(u4v*)(Xs + (lr + 32 * i) * 64 + lc * 8) = rx[i];
    }
#pragma unroll 1
    for (int c = cbeg; c < cbeg + LRU_SEGC; ++c) {
        const int jlo = dir ? (c < 4 ? LC - 64 - c * 64 : TB + LC - 64 - c * 64) : c * 64;
        if (c + 1 < cbeg + LRU_SEGC) {
            const int c1 = c + 1;
            const int jn = dir ? (c1 < 4 ? LC - 64 - c1 * 64 : TB + LC - 64 - c1 * 64) : c1 * 64;
            const int lo = (jn < LC) ? 0 : LC, hi = (jn < LC) ? LC : TB;
#pragma unroll
            for (int i = 0; i < 3; ++i) { int row = lr + 32 * i, jj = jn - 2 + row; rx[i] = (row < 67 && jj >= lo && jj < hi) ? *(const u4v*)(Z + (size_t)jj * ZP + ZXR + n * 64 + lc * 8) : (u4v){0u, 0u, 0u, 0u}; }
        }
        lds_barrier();
        {
            float u[16];
#pragma unroll
            for (int i = 0; i < 16; ++i) u[i] = CW[256 + ppart * 16 + i];
#pragma unroll
            for (int q = 0; q < 4; ++q) {
                const u4v x0 = *(const u4v*)(Xs + (ptok + q) * 64 + ppart * 16), x1 = *(const u4v*)(Xs + (ptok + q) * 64 + ppart * 16 + 8);
#pragma unroll
                for (int i = 0; i < 4; ++i) {
                    u[2 * i] += CW[q * 64 + ppart * 16 + 2 * i] * lo16(x0[i]); u[2 * i + 1] += CW[q * 64 + ppart * 16 + 2 * i + 1] * hi16(x0[i]);
                    u[8 + 2 * i] += CW[q * 64 + ppart * 16 + 8 + 2 * i] * lo16(x1[i]); u[8 + 2 * i + 1] += CW[q * 64 + ppart * 16 + 8 + 2 * i + 1] * hi16(x1[i]);
                }
            }
            u4v w0, w1;
#pragma unroll
            for (int i = 0; i < 4; ++i) { w0[i] = pk2(u[2 * i], u[2 * i + 1]); w1[i] = pk2(u[8 + 2 * i], u[8 + 2 * i + 1]); }
            *(u4v*)(Us + ptok * GP + ppart * 16) = w0; *(u4v*)(Us + ptok * GP + ppart * 16 + 8) = w1;
        }
        lds_barrier();
        {
            f4v ga[4], gx[4];
#pragma unroll
            for (int nj = 0; nj < 4; ++nj) { ga[nj] = (f4v){0.f, 0.f, 0.f, 0.f}; gx[nj] = (f4v){0.f, 0.f, 0.f, 0.f}; }
#pragma unroll
            for (int ks = 0; ks < 2; ++ks) {
                const s8v af = *(const s8v*)(Us + (wave * 16 + l15) * GP + ks * 32 + gq * 8);
#pragma unroll
                for (int nj = 0; nj < 4; ++nj) { ga[nj] = MFMA16(af, wfa[nj][ks], ga[nj]); gx[nj] = MFMA16(af, *(const s8v*)(WXs + (nj * 16 + l15) * GP + ks * 32 + gq * 8), gx[nj]); }
            }
#pragma unroll
            for (int nj = 0; nj < 4; ++nj)
#pragma unroll
                for (int q = 0; q < 4; ++q) {
                    const int tok = wave * 16 + gq * 4 + q, ch = nj * 16 + l15;
                    const float uu = bf2f(Us[tok * GP + ch]);
                    const float rg = __builtin_amdgcn_rcpf(1.f + __expf(-(ga[nj][q] + cba[nj]))), ig = __builtin_amdgcn_rcpf(1.f + __expf(-(gx[nj][q] + cbx[nj])));
                    const float av_ = __expf(-8.f * rg * csp[nj]);
                    Aa[tok * 64 + ch] = av_;
                    Bb[tok * 64 + ch] = __builtin_amdgcn_sqrtf(fmaxf(1.f - av_ * av_, 0.f)) * (ig * uu);
                }
        }
        lds_barrier();
        {
            const int tb = dir ? (63 - wave * 16) : wave * 16;
            const int a0 = tb * 64 + lane;
            float ap = 1.f, hl = 0.f;
            if (dir) seg_aggr<-64>(Aa, Bb, a0, ap, hl); else seg_aggr<64>(Aa, Bb, a0, ap, hl);
            SAg[wave * 64 + lane] = ap; SBg[wave * 64 + lane] = hl;
            lds_barrier();
            float hin = h, ainw = ain, hc = h, ac = ain;
#pragma unroll
            for (int w2 = 0; w2 < 4; ++w2) { if (w2 == wave) { hin = hc; ainw = ac; } const float sa = SAg[w2 * 64 + lane]; hc = sa * hc + SBg[w2 * 64 + lane]; ac *= sa; }
            h = hc; ain = ac;
            if (dir) seg_apply<-64>(Aa, Bb, a0, hin, ainw); else seg_apply<64>(Aa, Bb, a0, hin, ainw);
        }
        lds_barrier();
        {
#pragma unroll
            for (int i = 0; i < 4; ++i) {
                *(f4v*)(HL + (size_t)(jlo + ptok) * 256 + ppart * 16 + i * 4) = *(const f4v*)(Aa + ptok * 64 + ppart * 16 + i * 4);
                *(f4v*)(AC + (size_t)(jlo + ptok) * 256 + ppart * 16 + i * 4) = *(const f4v*)(Bb + ptok * 64 + ppart * 16 + i * 4);
            }
        }
        if (c + 1 < cbeg + LRU_SEGC) {
#pragma unroll
            for (int i = 0; i < 3; ++i) if (lr + 32 * i < 68) *(u4v*)(Xs + (lr + 32 * i) * 64 + lc * 8) = rx[i];
        }
    }
    if (wave == 0) {
        float* ag = (float*)(p.ws + WS_AGG) + ((size_t)(((b * 4 + n) * 2 + dir) * LRU_NSEG + seg)) * 128;
        ag[lane] = h; ag[64 + lane] = ain;
    }
    lds_barrier();
}

__device__ __forceinline__ void phase_lru_combine(const Params& p, int l) {
    const int tid = tid_op();
    const float* HLb = (const float*)(p.ws + WS_HF);
    const float* HLb1 = (const float*)(p.ws + WS_H);
    const float* AG = (const float*)(p.ws + WS_AGG);
    const bf16* Zb = (const bf16*)(p.ws + WS_Z);
    bf16* Yb = (bf16*)(p.ws + WS_Y);
    for (int u = blockIdx.x * 256 + tid; u < M * 32; u += gridDim.x * 256) {
        const int r = u >> 5, g = u & 31, b = r / TB, j = r - b * TB;
        if (l == 1 && j < LC) continue;
        const int ch0 = g * 8, n = ch0 >> 6, cl = ch0 & 63;
        const int seg0 = (j >> 6) / LRU_SEGC;
        const int c1 = (j < LC) ? 3 - (j >> 6) : 135 - (j >> 6);
        const int seg1 = c1 / LRU_SEGC;
        float car0[8], car1[8];
#pragma unroll
        for (int i = 0; i < 8; ++i) { car0[i] = 0.f; car1[i] = 0.f; }
        for (int s = 0; s < seg0; ++s) {
            const float* ag = AG + ((size_t)(((b * 4 + n) * 2 + 0) * LRU_NSEG + s)) * 128 + cl;
#pragma unroll
            for (int i = 0; i < 8; ++i) car0[i] = ag[64 + i] * car0[i] + ag[i];
        }
        for (int s = 0; s < seg1; ++s) {
            const float* ag = AG + ((size_t)(((b * 4 + n) * 2 + 1) * LRU_NSEG + s)) * 128 + cl;
#pragma unroll
            for (int i = 0; i < 8; ++i) car1[i] = ag[64 + i] * car1[i] + ag[i];
        }
        const size_t ro = (size_t)r * 256 + ch0;
        const f4v h0a = *(const f4v*)(HLb + ro), h0b = *(const f4v*)(HLb + ro + 4);
        const f4v a0a = *(const f4v*)(HLb + (size_t)M * 256 + ro), a0b = *(const f4v*)(HLb + (size_t)M * 256 + ro + 4);
        const f4v h1a = *(const f4v*)(HLb1 + ro), h1b = *(const f4v*)(HLb1 + ro + 4);
        const f4v a1a = *(const f4v*)(HLb1 + (size_t)M * 256 + ro), a1b = *(const f4v*)(HLb1 + (size_t)M * 256 + ro + 4);
        const u4v xg = *(const u4v*)(Zb + (size_t)r * ZP + ZXG + ch0);
        float y[8];
#pragma unroll
        for (int i = 0; i < 4; ++i) {
            y[i] = (h0a[i] + a0a[i] * car0[i]) + (h1a[i] + a1a[i] * car1[i]);
            y[4 + i] = (h0b[i] + a0b[i] * car0[4 + i]) + (h1b[i] + a1b[i] * car1[4 + i]);
        }
        u4v o;
#pragma unroll
        for (int i = 0; i < 4; ++i) o[i] = pk2(y[2 * i] * gelu_t(lo16(xg[i])), y[2 * i + 1] * gelu_t(hi16(xg[i])));
        *(u4v*)(Yb + (size_t)r * D + 768 + ch0) = o;
    }
}

__device__ __forceinline__ void phase_mixers_fast(const Params& p, int l, unsigned char* smem, int* s_item, int ctr_off) {
    const int tid = threadIdx.x;
    float* biasLds = (float*)(smem + BIAS_OFF_B);
    for (int i = tid; i < 4 * 465; i += 256) biasLds[i] = p.na_bias[(size_t)l * 4 * 465 + i];
    unsigned* ctr = (unsigned*)(p.ws + WS_CTL) + l + ctr_off;
    const int nctx = (l == 0) ? 48 : 0;
    const int total = 512 + LRU_ITEMS + 2 * 512 + nctx;
    __syncthreads();
    while (true) {
        if (tid == 0) *s_item = (int)atomicAdd(ctr, 1u);
        __syncthreads();
        const int item = *s_item;
        __syncthreads();
        if (item >= total) break;
        if (item < 512) {
            const int b = item >> 7, rem = item & 127;
            attn_item_fast<1>(p, l, b, rem >> 6, rem & 63, false, (bf16*)smem, biasLds);
        } else if (item < 512 + LRU_ITEMS) {
            const int v = item - 512;
            const int seg = v % LRU_NSEG, w = v / LRU_NSEG;
            lru_item_fast(p, l, w >> 3, (w >> 1) & 3, w & 1, seg, smem);
        } else if (item < 512 + LRU_ITEMS + 1024) {
            const int v = item - 512 - LRU_ITEMS, idx = v & 511;
            const int b = idx >> 7, rem = idx & 127;
            if (v < 512) attn_item_fast<2>(p, l, b, rem >> 5, rem & 31, false, (bf16*)smem, biasLds);
            else attn_item_fast<0>(p, l, b, rem >> 6, rem & 63, false, (bf16*)smem, biasLds);
        } else {
            const int v = item - 512 - LRU_ITEMS - 1024, ko = v >> 4, rem = v & 15;
            const int kind = (ko == 0) ? 1 : (ko == 1 ? 0 : 2);
            const int b = rem >> 2, x = rem & 3;
            if (kind == 2) attn_item_fast<2>(p, l, b, x, 0, true, (bf16*)smem, biasLds);
            else if (kind == 1) attn_item_fast<1>(p, l, b, x >> 1, x & 1, true, (bf16*)smem, biasLds);
            else attn_item_fast<0>(p, l, b, x >> 1, x & 1, true, (bf16*)smem, biasLds);
        }
        __syncthreads();
    }
}

__device__ __forceinline__ void fp8x16_to_f32(const u4v w, float (&f)[16]) {
#pragma unroll
    for (int i = 0; i < 4; ++i) {
        const f2v lo = __builtin_amdgcn_cvt_pk_f32_fp8((int)w[i], false), hi = __builtin_amdgcn_cvt_pk_f32_fp8((int)w[i], true);
        f[i * 4] = lo[0]; f[i * 4 + 1] = lo[1]; f[i * 4 + 2] = hi[0]; f[i * 4 + 3] = hi[1];
    }
}
__device__ __forceinline__ float xch32(float v, int lane) {
    const unsigned b = __float_as_uint(v);
    const auto r = __builtin_amdgcn_permlane32_swap(b, b, false, false);
    return __uint_as_float((lane & 32) ? r[0] : r[1]);
}
__device__ __forceinline__ float xch16(float v, int lane) {
    const unsigned b = __float_as_uint(v);
    const auto r = __builtin_amdgcn_permlane16_swap(b, b, false, false);
    return __uint_as_float((lane & 16) ? r[0] : r[1]);
}
template <int CTRL>
__device__ __forceinline__ float dppf(float v) { return __uint_as_float((unsigned)__builtin_amdgcn_update_dpp(0, (int)__float_as_uint(v), CTRL, 0xF, 0xF, false)); }
__device__ __forceinline__ float xch8(float v) { return dppf<0x128>(v); }
__device__ __forceinline__ float xch4(float v) { return dppf<0x1B>(dppf<0x141>(v)); }
__device__ __forceinline__ float xch2(float v) { return dppf<0x4E>(v); }
__device__ __forceinline__ float xch1(float v) { return dppf<0xB1>(v); }

__device__ __forceinline__ void phase_peer(const Params& p, int l) {
    const int tidx = tid_op(), lane = tidx & 63, gw = blockIdx.x * 4 + __builtin_amdgcn_readfirstlane(tidx >> 6), nw = gridDim.x * 4;
    const bf16* H = (const bf16*)(p.ws + WS_H);
    const unsigned char* U = p.ws + WS_U + (size_t)l * NE * D;
    const unsigned char* V = p.ws + WS_V + (size_t)l * NE * D;
    const float* US = (const float*)(p.ws + WS_US) + (size_t)l * NE;
    const float* VS = (const float*)(p.ws + WS_VS) + (size_t)l * NE;
    const float* stop = (const float*)(p.ws + WS_STOP);
    const unsigned char* itop = p.ws + WS_ITOP;
    const float* modv = (const float*)(p.ws + WS_MOD);
    const int ci = (lane >= 16) + (lane >= 24) + (lane >= 29) + (lane >= 33) + (lane >= 36) + (lane >= 38) + (lane >= 40) + (lane >= 42)
                 + (lane >= 43) + (lane >= 44) + (lane >= 45) + (lane >= 46) + (lane >= 47) + (lane >= 48) + (lane >= 49);
    const int cpre = (ci == 0) ? 0 : (ci == 1) ? 16 : (ci == 2) ? 24 : (ci == 3) ? 29 : (ci == 4) ? 33 : (ci == 5) ? 36 : (ci == 6) ? 38 : (ci == 7) ? 40 : 34 + ci;
    const int cj = (lane - cpre) & 15;
    const bool cvalid = lane < 50;
    for (int r = gw; r < M; r += nw) {
        const int mi = mod_idx(r);
        if (l == 1 && mi == 4) continue;
        float hf[16];
        {
            const bf16* hrow = H + (size_t)r * D + lane * 16;
            const u4v h0 = *(const u4v*)hrow, h1 = *(const u4v*)(hrow + 8);
#pragma unroll
            for (int i = 0; i < 4; ++i) { hf[2 * i] = lo16(h0[i]); hf[2 * i + 1] = hi16(h0[i]); hf[8 + 2 * i] = lo16(h1[i]); hf[8 + 2 * i + 1] = hi16(h1[i]); }
        }
        float out[16];
#pragma unroll
        for (int i = 0; i < 16; ++i) out[i] = 0.f;
        float st_n = -3e38f; int it_n = 0;
        if (lane < 32) { st_n = stop[(size_t)r * 256 + lane]; it_n = itop[(size_t)r * 256 + lane]; }
#pragma unroll 1
        for (int hh = 0; hh < 8; ++hh) {
            const float st = st_n; const int it = it_n;
            if (hh + 1 < 8 && lane < 32) { st_n = stop[(size_t)r * 256 + (hh + 1) * 32 + lane]; it_n = itop[(size_t)r * 256 + (hh + 1) * 32 + lane]; }
            const float cand = cvalid ? __shfl(st, ci) + __shfl(st, 16 + cj) : -3e38f;
            const int ecand = __shfl(it, ci) * 128 + __shfl(it, 16 + cj);
            const unsigned key = (f2ord(cand) & ~63u) | (unsigned)(63 - lane);
            unsigned thr = 0u;
#pragma unroll
            for (int bit = 31; bit >= 0; --bit) {
                const unsigned t = thr | (1u << bit);
                if (__popcll(__ballot(key >= t)) >= 16) thr = t;
            }
            const bool sel = key >= thr;
            const unsigned long long selm = __ballot(sel);
            const unsigned long long m2 = sel ? selm : ~selm;
            const int rank = __builtin_amdgcn_mbcnt_hi((unsigned)(m2 >> 32), __builtin_amdgcn_mbcnt_lo((unsigned)m2, 0u));
            const int dst = sel ? rank : 16 + rank;
            const float smax = __uint_as_float(__builtin_amdgcn_readlane(__float_as_uint(cand), 0));
            const float mys = __uint_as_float(__builtin_amdgcn_ds_permute(dst * 4, __float_as_uint(cand)));
            const int e = __builtin_amdgcn_ds_permute(dst * 4, ecand);
            const float su = US[e], sv = VS[e];
            float ex = (lane < 16) ? __expf(mys - smax) : 0.f;
            float esum = ex;
            esum += xch8(esum); esum += xch4(esum); esum += xch2(esum); esum += xch1(esum);
            float gate = (lane < 16) ? ex / esum : 0.f;
            u4v ur[16], vr[16];
#pragma unroll
            for (int k = 0; k < 16; ++k) { const int ek = __builtin_amdgcn_readlane(e, k); ur[k] = *(const u4v*)(U + (size_t)ek * D + lane * 16); }
#pragma unroll
            for (int k = 0; k < 16; ++k) { const int ek = __builtin_amdgcn_readlane(e, k); vr[k] = *(const u4v*)(V + (size_t)ek * D + lane * 16); }
            float part[16];
#pragma unroll
            for (int k = 0; k < 16; ++k) {
                f2v a2 = {0.f, 0.f};
#pragma unroll
                for (int i = 0; i < 4; ++i) {
                    const f2v lo = __builtin_amdgcn_cvt_pk_f32_fp8((int)ur[k][i], false), hi = __builtin_amdgcn_cvt_pk_f32_fp8((int)ur[k][i], true);
                    a2 += lo * (f2v){hf[i * 4], hf[i * 4 + 1]};
                    a2 += hi * (f2v){hf[i * 4 + 2], hf[i * 4 + 3]};
                }
                part[k] = a2[0] + a2[1];
            }
            float q8[8], q4[4], q2[2], q1;
            { const bool hi = (lane & 32) != 0;
#pragma unroll
              for (int k = 0; k < 8; ++k) { float send = hi ? part[k] : part[k + 8], keep = hi ? part[k + 8] : part[k]; q8[k] = keep + xch32(send, lane); } }
            { const bool hi = (lane & 16) != 0;
#pragma unroll
              for (int k = 0; k < 4; ++k) { float send = hi ? q8[k] : q8[k + 4], keep = hi ? q8[k + 4] : q8[k]; q4[k] = keep + xch16(send, lane); } }
            { const bool hi = (lane & 8) != 0;
#pragma unroll
              for (int k = 0; k < 2; ++k) { float send = hi ? q4[k] : q4[k + 2], keep = hi ? q4[k + 2] : q4[k]; q2[k] = keep + xch8(send); } }
            { const bool hi = (lane & 4) != 0; float send = hi ? q2[0] : q2[1], keep = hi ? q2[1] : q2[0]; q1 = keep + xch4(send); }
            q1 += xch2(q1); q1 += xch1(q1);
            const int kk = (lane >> 2) & 15;
            const float coef = gelu_t(q1 * __shfl(su, kk)) * __shfl(gate, kk) * __shfl(sv, kk);
#pragma unroll
            for (int k = 0; k < 16; ++k) {
                const float ck = __uint_as_float(__builtin_amdgcn_readlane(__float_as_uint(coef), 4 * k));
                float vf[16];
                fp8x16_to_f32(vr[k], vf);
#pragma unroll
                for (int i = 0; i < 16; ++i) out[i] += ck * vf[i];
            }
        }
        float* xr = xs_row(p, r) + lane * 16;
        float xv[16];
#pragma unroll
        for (int i = 0; i < 4; ++i) { const float4 t = *(const float4*)(xr + i * 4); xv[i * 4] = t.x; xv[i * 4 + 1] = t.y; xv[i * 4 + 2] = t.z; xv[i * 4 + 3] = t.w; }
        const float* mv = modv + ((size_t)l * 5 + mi) * 6144;
#pragma unroll
        for (int i = 0; i < 16; ++i) xv[i] += mv[5120 + lane * 16 + i] * out[i];
        float ss = 0.f;
#pragma unroll
        for (int i = 0; i < 16; ++i) ss += xv[i] * xv[i];
        ss = wave_sum(ss);
        const float rstd = rsqrtf(ss * (1.f / 1024.f) + EPS);
        if (l == 0) {
#pragma unroll
            for (int i = 0; i < 4; ++i) *(float4*)(xr + i * 4) = make_float4(xv[i * 4], xv[i * 4 + 1], xv[i * 4 + 2], xv[i * 4 + 3]);
            const float* mv1 = modv + ((size_t)1 * 5 + mi) * 6144;
            const float* g = p.norm_mix + D;
            float o[16];
#pragma unroll
            for (int i = 0; i < 16; ++i) { const int e0 = lane * 16 + i; o[i] = xv[i] * rstd * g[e0] * (1.f + mv1[1024 + e0]) + mv1[e0]; }
            u4v w0, w1;
#pragma unroll
            for (int i = 0; i < 4; ++i) { w0[i] = pk2(o[2 * i], o[2 * i + 1]); w1[i] = pk2(o[8 + 2 * i], o[8 + 2 * i + 1]); }
            bf16* hrow = (bf16*)(p.ws + WS_H) + (size_t)r * D + lane * 16;
            *(u4v*)hrow = w0; *(u4v*)(hrow + 8) = w1;
        } else {
#pragma unroll
            for (int i = 0; i < 4; ++i) {
                const float4 g4 = *(const float4*)(p.norm_final + lane * 16 + i * 4);
                *(float4*)(xr + i * 4) = make_float4(xv[i * 4] * rstd * g4.x, xv[i * 4 + 1] * rstd * g4.y, xv[i * 4 + 2] * rstd * g4.z, xv[i * 4 + 3] * rstd * g4.w);
            }
        }
    }
}

__device__ __forceinline__ void grid_bar(unsigned* ctl, unsigned& gen) {
    __syncthreads();
    gen += 1;
    unsigned* arrive = ctl + 256;
    unsigned* release = ctl + 896;
    if (threadIdx.x == 0) {
        __threadfence();
        __hip_atomic_store(arrive + blockIdx.x, gen, __ATOMIC_RELAXED, __HIP_MEMORY_SCOPE_AGENT);
    }
    if (blockIdx.x == 0) {
        for (unsigned i = threadIdx.x; i < gridDim.x; i += 256)
            while (__hip_atomic_load(arrive + i, __ATOMIC_RELAXED, __HIP_MEMORY_SCOPE_AGENT) < gen) __builtin_amdgcn_s_sleep(1);
        __syncthreads();
        if (threadIdx.x == 0) __hip_atomic_store(release, gen, __ATOMIC_RELAXED, __HIP_MEMORY_SCOPE_AGENT);
    }
    if (threadIdx.x == 0) {
        while (__hip_atomic_load(release, __ATOMIC_RELAXED, __HIP_MEMORY_SCOPE_AGENT) < gen) __builtin_amdgcn_s_sleep(1);
        __threadfence();
    }
    __syncthreads();
}

#ifndef DUP_MASK
#define DUP_MASK 0
#endif
__global__ void __launch_bounds__(256, 2) fwd_megakernel(Params p) {
    __shared__ __attribute__((aligned(16))) unsigned char smem[SMEM_BYTES];
    float* lds = (float*)smem;
    __shared__ int s_item;
    cg::grid_group grid = cg::this_grid();
    unsigned* gbar = (unsigned*)(p.ws + WS_CTL);
    unsigned gtarget = 0;
    phase0(p, lds);
    grid.sync();
    if (DUP_MASK & 1) { phase0(p, lds); grid_bar(gbar, gtarget); }
    phase_rownorm(p, 0, 0);
    grid_bar(gbar, gtarget);
#pragma unroll 1
    for (int l = 0; l < 2; ++l) {
        phase_inproj_fast(p, l, (bf16*)smem);
        grid_bar(gbar, gtarget);
        if (DUP_MASK & 2) { phase_inproj_fast(p, l, (bf16*)smem); grid_bar(gbar, gtarget); }
        phase_mixers_fast(p, l, smem, &s_item, 0);
        grid_bar(gbar, gtarget);
        if (DUP_MASK & 4) { phase_mixers_fast(p, l, smem, &s_item, 2); grid_bar(gbar, gtarget); }
        phase_lru_combine(p, l);
        grid_bar(gbar, gtarget);
        phase_outproj_fast(p, l, (bf16*)smem);
        grid_bar(gbar, gtarget);
        if ((DUP_MASK & 32) && l == 0) { phase_outproj_fast(p, l, (bf16*)smem); grid_bar(gbar, gtarget); }
        phase_rownorm(p, l, 1);
        grid_bar(gbar, gtarget);
        if (DUP_MASK & 16) { phase_rownorm(p, l, 1); grid_bar(gbar, gtarget); }
        phase_peerq_fast(p, l, (bf16*)smem);
        grid_bar(gbar, gtarget);
        if (DUP_MASK & 8) { phase_peerq_fast(p, l, (bf16*)smem); grid_bar(gbar, gtarget); }
        phase_peer(p, l);
        if (l == 0) grid_bar(gbar, gtarget);
    }
}

extern "C" void kernel_launch(void* const* d_in, const int* in_sizes, int n_in, void* d_out, int out_size, void* d_ws, size_t ws_size, hipStream_t stream) {
    static int grid_blocks = 0;
    if (!grid_blocks) {
        int dev = 0, cus = 0, per_cu = 0;
        hipGetDevice(&dev);
        hipDeviceGetAttribute(&cus, hipDeviceAttributeMultiprocessorCount, dev);
        hipOccupancyMaxActiveBlocksPerMultiprocessor(&per_cu, fwd_megakernel, 256, 0);
        if (per_cu > 2) per_cu = 2;
        if (per_cu < 1) per_cu = 1;
        grid_blocks = cus * per_cu;
        if (grid_blocks > 512) grid_blocks = 512;
        if (ws_size < WS_END) fprintf(stderr, "kernel_launch: workspace too small: need %zu have %zu\n", (size_t)WS_END, ws_size);
    }
    Params p{};
    const float** pp = (const float**)&p;
    for (int i = 0; i < 26; ++i) pp[i] = (const float*)d_in[i];
    p.out = (float*)d_out;
    p.ws = (unsigned char*)d_ws;
    (void)hipMemsetAsync((char*)d_ws + WS_CTL, 0, 4096, stream);
    void* args[] = {&p};
    hipError_t e = hipLaunchCooperativeKernel((void*)fwd_megakernel, dim3(grid_blocks), dim3(256), args, 0, stream);
    if (e != hipSuccess) fprintf(stderr, "cooperative launch failed: %s (grid %d)\n", hipGetErrorString(e), grid_blocks);
}
```

```cpp
#include <hip/hip_runtime.h>
#include <hip/hip_cooperative_groups.h>
#include <cstdio>
#include <cstdint>
namespace cg = cooperative_groups;

typedef unsigned short bf16;
typedef __bf16 bf2_t __attribute__((ext_vector_type(2)));
typedef unsigned u4v __attribute__((ext_vector_type(4)));

constexpr int D = 1024, NB = 4, SEQ = 8192, LC = 256, TB = SEQ + LC  , M = NB * TB  ;
constexpr int DIN = 2304, ZP = 1792;
constexpr int NE = 16384;
constexpr int ZQA = 0, ZKA = 256, ZQB = 384, ZKB = 640, ZQN = 768, ZKN = 1024, ZXR = 1280, ZXG = 1536;
constexpr float EPS = 1e-6f;

constexpr size_t al(size_t x) { return (x + 255) & ~(size_t)255; }
constexpr size_t WS_CTL = 0;
constexpr size_t WS_WIN = 4096;
constexpr size_t WS_WOUT = WS_WIN + al((size_t)2 * DIN * D * 2);
constexpr size_t WS_WQ = WS_WOUT + al((size_t)2 * D * D * 2);
constexpr size_t WS_KEYS = WS_WQ + al((size_t)2 * 2048 * D * 2);
constexpr size_t WS_LRUW = WS_KEYS + al((size_t)2 * 2 * 128 * 128 * 2);
constexpr size_t WS_U = WS_LRUW + al((size_t)2 * 2 * 2 * 4 * 4096 * 2);
constexpr size_t WS_V = WS_U + al((size_t)2 * NE * D);
constexpr size_t WS_US = WS_V + al((size_t)2 * NE * D);
constexpr size_t WS_VS = WS_US + al((size_t)2 * NE * 4);
constexpr size_t WS_MOD = WS_VS + al((size_t)2 * NE * 4);
constexpr size_t WS_ROPE = WS_MOD + al((size_t)2 * 5 * 6144 * 4);
constexpr size_t WS_H = WS_ROPE + al((size_t)128 * 16 * 8);
constexpr size_t WS_Z = WS_H + al((size_t)M * D * 2);
constexpr size_t WS_VTA = WS_Z + al((size_t)M * ZP * 2);
constexpr size_t WS_VTB = WS_VTA + al((size_t)NB * 2 * 64 * TB * 2);
constexpr size_t WS_VTN = WS_VTB + al((size_t)NB * 2 * 64 * TB * 2);
constexpr size_t WS_Y = WS_VTN + al((size_t)NB * 4 * 64 * TB * 2);
constexpr size_t WS_HF = WS_Y + al((size_t)M * D * 2);
constexpr size_t WS_AGG = WS_HF + al((size_t)2 * M * 256 * 4);
constexpr size_t WS_XC = WS_AGG + al((size_t)16 * 2 * 12 * 2 * 64 * 4);
constexpr size_t WS_END = WS_XC + al((size_t)NB * LC * D * 4);
constexpr size_t WS_STOP = WS_Z;
constexpr size_t WS_ITOP = WS_Z + al((size_t)M * 256 * 4);

struct Params {
    const float *x, *c, *ctx, *c_ctx, *w_mod, *b_mod, *norm_mix, *norm_ffn, *w_in, *w_out, *attn_sink, *qn_g, *kn_g, *na_bias,
        *conv_w, *conv_b, *lru_wa, *lru_ba, *lru_wx, *lru_bx, *lru_lam, *peer_wq, *peer_keys, *peer_u, *peer_v, *norm_final;
    float* out;
    unsigned char* ws;
};

__device__ __forceinline__ float bf2f(bf16 v) { return __uint_as_float((unsigned)v << 16); }
__device__ __forceinline__ bf16 f2bf(float f) { unsigned u = __float_as_uint(f); return (bf16)((u + 0x7fffu + ((u >> 16) & 1u)) >> 16); }
typedef __bf16 bf16x2_t __attribute__((ext_vector_type(2)));
typedef float f32x2_t __attribute__((ext_vector_type(2)));
__device__ __forceinline__ unsigned pk2(float lo, float hi) { f32x2_t v = {lo, hi}; return __builtin_bit_cast(unsigned, __builtin_convertvector(v, bf16x2_t)); }
__device__ __forceinline__ float lo16(unsigned w) { return __uint_as_float(w << 16); }
__device__ __forceinline__ float hi16(unsigned w) { return __uint_as_float(w & 0xffff0000u); }
__device__ __forceinline__ float dot2(unsigned a, unsigned b, float c) { return __builtin_amdgcn_fdot2_f32_bf16(__builtin_bit_cast(bf2_t, a), __builtin_bit_cast(bf2_t, b), c, false); }
__device__ __forceinline__ float dot8(uint4 a, uint4 b, float c) { c = dot2(a.x, b.x, c); c = dot2(a.y, b.y, c); c = dot2(a.z, b.z, c); return dot2(a.w, b.w, c); }
__device__ __forceinline__ float wave_sum(float v) {
#pragma unroll
    for (int o = 32; o > 0; o >>= 1) v += __shfl_xor(v, o);
    return v;
}
__device__ __forceinline__ float wave_max(float v) {
#pragma unroll
    for (int o = 32; o > 0; o >>= 1) v = fmaxf(v, __shfl_xor(v, o));
    return v;
}
__device__ __forceinline__ float gelu_t(float x) { float u = 0.7978845608028654f * (x + 0.044715f * x * x * x); return x * __builtin_amdgcn_rcpf(1.f + __expf(-2.f * u)); }
__device__ __forceinline__ float sigmoidf_(float x) { return 1.f / (1.f + __expf(-x)); }

__device__ __forceinline__ int tid_op() { int t = threadIdx.x; asm volatile("" : "+v"(t)); return t; }

__device__ __forceinline__ void lds_barrier() { asm volatile("s_waitcnt lgkmcnt(0)\n\ts_barrier" ::: "memory"); }

__device__ __forceinline__ const float* in_row(const Params& p, int r) {
    int b = r / TB, j = r - b * TB;
    return (j < LC) ? p.ctx + ((size_t)b * LC + j) * D : p.x + ((size_t)b * SEQ + (j - LC)) * D;
}
__device__ __forceinline__ float* xs_row(const Params& p, int r) {
    int b = r / TB, j = r - b * TB;
    return (j < LC) ? (float*)(p.ws + WS_XC) + ((size_t)b * LC + j) * D : p.out + ((size_t)b * SEQ + (j - LC)) * D;
}
__device__ __forceinline__ int mod_idx(int r) { int b = r / TB, j = r - b * TB; return (j < LC) ? 4 : b; }

__device__ __forceinline__ void p0_mod(const Params& p, float* lds) {
    float* sv = lds;
    float* red = lds + 5 * 1024;
    const int tid = threadIdx.x, lane = tid & 63, wave = tid >> 6;
    for (int i = tid; i < 5 * 1024; i += 256) {
        int bi = i >> 10, k = i & 1023;
        float v = (bi < 4) ? p.c[bi * 1024 + k] : p.c_ctx[k];
        sv[i] = v / (1.f + __expf(-v));
    }
    __syncthreads();
    float* modv = (float*)(p.ws + WS_MOD);
    for (int it = blockIdx.x; it < 2 * 96; it += gridDim.x) {
        int l = it / 96, col = (it % 96) * 64 + lane;
        const float* w = p.w_mod + (size_t)l * D * 6144 + col;
        float a0 = 0, a1 = 0, a2 = 0, a3 = 0, a4 = 0;
        int k0 = wave * 256;
#pragma unroll 8
        for (int k = k0; k < k0 + 256; ++k) {
            float wv = w[(size_t)k * 6144];
            a0 += sv[k] * wv; a1 += sv[1024 + k] * wv; a2 += sv[2048 + k] * wv; a3 += sv[3072 + k] * wv; a4 += sv[4096 + k] * wv;
        }
        red[(wave * 5 + 0) * 64 + lane] = a0; red[(wave * 5 + 1) * 64 + lane] = a1; red[(wave * 5 + 2) * 64 + lane] = a2;
        red[(wave * 5 + 3) * 64 + lane] = a3; red[(wave * 5 + 4) * 64 + lane] = a4;
        __syncthreads();
        for (int i = tid; i < 320; i += 256) {
            int bi = i / 64, cl = i % 64;
            float s = red[(0 * 5 + bi) * 64 + cl] + red[(1 * 5 + bi) * 64 + cl] + red[(2 * 5 + bi) * 64 + cl] + red[(3 * 5 + bi) * 64 + cl];
            int cc = (it % 96) * 64 + cl;
            modv[((size_t)l * 5 + bi) * 6144 + cc] = s + p.b_mod[l * 6144 + cc];
        }
        __syncthreads();
    }
}
__device__ __forceinline__ void p0_transpose(const float* src, bf16* dst, int K, int N, int nmat, float* lds) {
    const int tid = threadIdx.x;
    const int tk = K / 64, tn = N / 64, per = tk * tn;
    for (int it = blockIdx.x; it < nmat * per; it += gridDim.x) {
        int mat = it / per, t = it % per, k0 = (t / tn) * 64, n0 = (t % tn) * 64;
        const float* s = src + (size_t)mat * K * N;
        bf16* d = dst + (size_t)mat * K * N;
        for (int i = tid; i < 4096; i += 256) { int kk = i >> 6, nn = i & 63; lds[kk * 65 + nn] = s[(size_t)(k0 + kk) * N + n0 + nn]; }
        __syncthreads();
        for (int i = tid; i < 4096; i += 256) { int nn = i >> 6, kk = i & 63; d[(size_t)(n0 + nn) * K + k0 + kk] = f2bf(lds[kk * 65 + nn]); }
        __syncthreads();
    }
}
__device__ __forceinline__ void p0_convert(const float* src, bf16* dst, size_t n) {
    size_t i = ((size_t)blockIdx.x * 256 + threadIdx.x) * 4, st = (size_t)gridDim.x * 256 * 4;
    for (; i < n; i += st) {
        float4 v = *(const float4*)(src + i);
        uint2 o; o.x = pk2(v.x, v.y); o.y = pk2(v.z, v.w);
        *(uint2*)(dst + i) = o;
    }
}

typedef float f2v __attribute__((ext_vector_type(2)));
__device__ __forceinline__ void p0_convert_fp8(const float* src, unsigned char* dst, float* scales, int nrows) {
    const int tidx = tid_op(), lane = tidx & 63, gw = blockIdx.x * 4 + __builtin_amdgcn_readfirstlane(tidx >> 6), nw = gridDim.x * 4;
    for (int r = gw; r < nrows; r += nw) {
        const float* row = src + (size_t)r * D + lane * 16;
        float v[16];
#pragma unroll
        for (int i = 0; i < 4; ++i) { float4 t = *(const float4*)(row + i * 4); v[i * 4] = t.x; v[i * 4 + 1] = t.y; v[i * 4 + 2] = t.z; v[i * 4 + 3] = t.w; }
        float am = 0.f;
#pragma unroll
        for (int i = 0; i < 16; ++i) am = fmaxf(am, fabsf(v[i]));
        am = wave_max(am);
        const float inv = (am > 0.f) ? 448.f / am : 1.f;
        u4v w;
#pragma unroll
        for (int i = 0; i < 4; ++i) {
            int t = 0;
            t = __builtin_amdgcn_cvt_pk_fp8_f32(v[i * 4] * inv, v[i * 4 + 1] * inv, t, false);
            t = __builtin_amdgcn_cvt_pk_fp8_f32(v[i * 4 + 2] * inv, v[i * 4 + 3] * inv, t, true);
            w[i] = (unsigned)t;
        }
        *(u4v*)(dst + (size_t)r * D + lane * 16) = w;
        if (lane == 0) scales[r] = (am > 0.f) ? am * (1.f / 448.f) : 1.f;
    }
}
__device__ __forceinline__ void phase0(const Params& p, float* lds) {
    p0_mod(p, lds);
    __syncthreads();
    p0_transpose(p.w_in, (bf16*)(p.ws + WS_WIN), D, DIN, 2, lds);
    p0_transpose(p.w_out, (bf16*)(p.ws + WS_WOUT), D, D, 2, lds);
    p0_transpose(p.peer_wq, (bf16*)(p.ws + WS_WQ), D, 2048, 2, lds);
    for (int g = 0; g < 2; ++g) {
        const float* src = g ? p.lru_wx : p.lru_wa;
        for (int ld = 0; ld < 4; ++ld)
            p0_transpose(src + (size_t)ld * 4 * 4096, (bf16*)(p.ws + WS_LRUW) + ((size_t)(ld * 2 + g) * 4) * 4096, 64, 64, 4, lds);
    }
    p0_convert(p.peer_keys, (bf16*)(p.ws + WS_KEYS), (size_t)2 * 2 * 128 * 128);
    p0_convert_fp8(p.peer_u, p.ws + WS_U, (float*)(p.ws + WS_US), 2 * NE);
    p0_convert_fp8(p.peer_v, p.ws + WS_V, (float*)(p.ws + WS_VS), 2 * NE);
    if (blockIdx.x == gridDim.x - 1) {
        float2* rt = (float2*)(p.ws + WS_ROPE);
        for (int i = threadIdx.x; i < 128 * 16; i += 256) {
            int pos = i >> 4, f = i & 15;
            float inv = powf(10000.f, -(float)f / 16.f);
            float ang = (float)pos * inv;
            rt[i] = make_float2(cosf(ang), sinf(ang));
        }
    }
}

__device__ __forceinline__ void modnorm_store(const float (&v)[16], const float* g, const float* sc, const float* sh, bf16* hrow, int lane) {
    float ss = 0;
#pragma unroll
    for (int i = 0; i < 16; ++i) ss += v[i] * v[i];
    ss = wave_sum(ss);
    float rstd = rsqrtf(ss * (1.f / 1024.f) + EPS);
#pragma unroll
    for (int hh = 0; hh < 2; ++hh) {
        int e0 = hh * 512 + lane * 8;
        float o[8];
#pragma unroll
        for (int i = 0; i < 8; ++i) o[i] = v[hh * 8 + i] * rstd * g[e0 + i] * (1.f + sc[e0 + i]) + sh[e0 + i];
        uint4 w; w.x = pk2(o[0], o[1]); w.y = pk2(o[2], o[3]); w.z = pk2(o[4], o[5]); w.w = pk2(o[6], o[7]);
        *(uint4*)(hrow + e0) = w;
    }
}
__device__ __forceinline__ void load_row16(const float* row, float (&v)[16], int lane) {
    float4 a = *(const float4*)(row + lane * 8), b = *(const float4*)(row + lane * 8 + 4);
    float4 c = *(const float4*)(row + 512 + lane * 8), d = *(const float4*)(row + 512 + lane * 8 + 4);
    v[0] = a.x; v[1] = a.y; v[2] = a.z; v[3] = a.w; v[4] = b.x; v[5] = b.y; v[6] = b.z; v[7] = b.w;
    v[8] = c.x; v[9] = c.y; v[10] = c.z; v[11] = c.w; v[12] = d.x; v[13] = d.y; v[14] = d.z; v[15] = d.w;
}
__device__ __forceinline__ void phase_rownorm(const Params& p, int l, int which) {
    const int tidx = tid_op(), lane = tidx & 63, gw = blockIdx.x * 4 + __builtin_amdgcn_readfirstlane(tidx >> 6), nw = gridDim.x * 4;
    const float* modv = (const float*)(p.ws + WS_MOD);
    bf16* H = (bf16*)(p.ws + WS_H);
    const int rpw = (M + nw - 1) / nw;
    const float* g = (which ? p.norm_ffn : p.norm_mix) + l * D;
    int cur_mi = -1;
    float gs[16], shv[16];
    for (int r = gw * rpw; r < (gw + 1) * rpw && r < M; ++r) {
        const int mi = mod_idx(r);
        if (l == 1 && which == 1 && mi == 4) continue;
        if (mi != cur_mi) {
            cur_mi = mi;
            const float* mv = modv + ((size_t)l * 5 + mi) * 6144;
            const float* sc = mv + (which ? 4096 : 1024); const float* sh = mv + (which ? 3072 : 0);
#pragma unroll
            for (int hh = 0; hh < 2; ++hh)
#pragma unroll
                for (int i = 0; i < 8; ++i) { const int e0 = hh * 512 + lane * 8 + i; gs[hh * 8 + i] = g[e0] * (1.f + sc[e0]); shv[hh * 8 + i] = sh[e0]; }
        }
        float v[16];
        load_row16(which ? xs_row(p, r) : in_row(p, r), v, lane);
        float ss = 0.f;
#pragma unroll
        for (int i = 0; i < 16; ++i) ss += v[i] * v[i];
        ss = wave_sum(ss);
        const float rstd = rsqrtf(ss * (1.f / 1024.f) + EPS);
        bf16* hrow = H + (size_t)r * D;
#pragma unroll
        for (int hh = 0; hh < 2; ++hh) {
            u4v w;
#pragma unroll
            for (int i = 0; i < 4; ++i) w[i] = pk2(v[hh * 8 + 2 * i] * rstd * gs[hh * 8 + 2 * i] + shv[hh * 8 + 2 * i], v[hh * 8 + 2 * i + 1] * rstd * gs[hh * 8 + 2 * i + 1] + shv[hh * 8 + 2 * i + 1]);
            *(u4v*)(hrow + hh * 512 + lane * 8) = w;
        }
    }
}

typedef short s8v __attribute__((ext_vector_type(8)));
typedef float f4v __attribute__((ext_vector_type(4)));
#define MFMA16(a, b, c) __builtin_amdgcn_mfma_f32_16x16x32_bf16((a), (b), (c), 0, 0, 0)
constexpr int GP = 72;
constexpr int TLDS = 128 * GP;
constexpr int SMEM_BYTES = 4 * TLDS * 2;

template <bool SWAP>
__device__ __forceinline__ void gemm_mainloop(const bf16* __restrict__ A, const bf16* __restrict__ Bt, bf16* lds, f4v (&acc)[4][4]) {
    const int tid = tid_op(), lane = tid & 63, wave = tid >> 6, wm = wave >> 1, wn = wave & 1;
    const int lrow = tid >> 3, lkc = tid & 7;
    const bf16* ag = A + (size_t)lrow * D + lkc * 8;
    const bf16* bg = Bt + (size_t)lrow * D + lkc * 8;
    bf16* sa = lds + lrow * GP + lkc * 8;
    u4v ra[4], rb[4];
#pragma unroll
    for (int i = 0; i < 4; ++i) { ra[i] = *(const u4v*)(ag + (size_t)i * 32 * D); rb[i] = *(const u4v*)(bg + (size_t)i * 32 * D); }
#pragma unroll
    for (int i = 0; i < 4; ++i) { *(u4v*)(sa + i * 32 * GP) = ra[i]; *(u4v*)(sa + TLDS + i * 32 * GP) = rb[i]; }
    __syncthreads();
    const int fro = (lane & 15) * GP + (lane >> 4) * 8;
#pragma unroll 1
    for (int kt = 0; kt < 16; ++kt) {
        const int buf = kt & 1;
        if (kt + 1 < 16) {
#pragma unroll
            for (int i = 0; i < 4; ++i) { ra[i] = *(const u4v*)(ag + (size_t)i * 32 * D + (kt + 1) * 64); rb[i] = *(const u4v*)(bg + (size_t)i * 32 * D + (kt + 1) * 64); }
        }
        const bf16* As = lds + buf * 2 * TLDS + wm * 64 * GP + fro;
        const bf16* Bs = lds + buf * 2 * TLDS + TLDS + wn * 64 * GP + fro;
#pragma unroll
        for (int ks = 0; ks < 2; ++ks) {
            s8v af[4], bfr[4];
#pragma unroll
            for (int i = 0; i < 4; ++i) { af[i] = *(const s8v*)(As + i * 16 * GP + ks * 32); bfr[i] = *(const s8v*)(Bs + i * 16 * GP + ks * 32); }
            __builtin_amdgcn_s_setprio(1);
#pragma unroll
            for (int mi = 0; mi < 4; ++mi)
#pragma unroll
                for (int nj = 0; nj < 4; ++nj)
                    acc[mi][nj] = SWAP ? MFMA16(bfr[nj], af[mi], acc[mi][nj]) : MFMA16(af[mi], bfr[nj], acc[mi][nj]);
            __builtin_amdgcn_s_setprio(0);
        }
        if (kt + 1 < 16) {
            bf16* sd = sa + (buf ^ 1) * 2 * TLDS;
#pragma unroll
            for (int i = 0; i < 4; ++i) { *(u4v*)(sd + i * 32 * GP) = ra[i]; *(u4v*)(sd + TLDS + i * 32 * GP) = rb[i]; }
        }
        __syncthreads();
    }
}

__device__ __forceinline__ void phase_inproj_fast(const Params& p, int l, bf16* lds) {
    const int tid = tid_op(), lane = tid & 63, wave = tid >> 6, wm = wave >> 1, wn = wave & 1, l15 = lane & 15, gq = lane >> 4;
    const bf16* H = (const bf16*)(p.ws + WS_H);
    const bf16* W = (const bf16*)(p.ws + WS_WIN) + (size_t)l * DIN * D;
    bf16* Z = (bf16*)(p.ws + WS_Z);
    const float2* rt = (const float2*)(p.ws + WS_ROPE);
    for (int tile = blockIdx.x; tile < 264 * 18; tile += gridDim.x) {
        const int mt = tile / 18, nt = tile - mt * 18;
        const bf16* A = H + (size_t)mt * 128 * D;
        const bf16* Bt = W + (size_t)nt * 128 * D;
        const int bb = mt / 66, jt = (mt - bb * 66) * 128;
        f4v acc[4][4];
#pragma unroll
        for (int i = 0; i < 4; ++i)
#pragma unroll
            for (int j = 0; j < 4; ++j) acc[i][j] = (f4v){0.f, 0.f, 0.f, 0.f};
        const int s = nt * 2 + wn;
        const bool isv = (nt == 3) || (nt == 7) || (nt == 12) || (nt == 13);
        if (isv) {
            gemm_mainloop<false>(A, Bt, lds, acc);
            int vkind, vh;
            if (s < 8) { vkind = 0; vh = s - 6; } else if (s < 16) { vkind = 1; vh = s - 14; } else { vkind = 2; vh = s - 24; }
            bf16* vt = (vkind == 0) ? (bf16*)(p.ws + WS_VTA) + ((size_t)(bb * 2 + vh) * 64) * TB
                     : (vkind == 1) ? (bf16*)(p.ws + WS_VTB) + ((size_t)(bb * 2 + vh) * 64) * TB
                                    : (bf16*)(p.ws + WS_VTN) + ((size_t)(bb * 4 + vh) * 64) * TB;
            bf16* stg = lds + wave * (64 * GP);
#pragma unroll
            for (int mi = 0; mi < 4; ++mi)
#pragma unroll
                for (int nj = 0; nj < 4; ++nj) {
                    uint2 w; w.x = pk2(acc[mi][nj][0], acc[mi][nj][1]); w.y = pk2(acc[mi][nj][2], acc[mi][nj][3]);
                    *(uint2*)(stg + (nj * 16 + l15) * GP + mi * 16 + gq * 4) = w;
                }
#pragma unroll
            for (int it = 0; it < 8; ++it) {
                const int rs = it * 8 + (lane >> 3), ch = lane & 7;
                *(u4v*)(vt + (size_t)rs * TB + jt + wm * 64 + ch * 8) = *(const u4v*)(stg + rs * GP + ch * 8);
            }
        } else {
            gemm_mainloop<true>(A, Bt, lds, acc);
            int zcol; bool nrm = false, rope = false, isq = false; const float* g = p.qn_g;
            if (s < 4) { zcol = ZQA + 64 * s; rope = true; isq = true; }
            else if (s < 6) { zcol = ZKA + 64 * (s - 4); rope = true; }
            else if (s < 12) { zcol = ZQB + 64 * (s - 8); rope = true; isq = true; nrm = true; g = p.qn_g + l * 64; }
            else if (s < 14) { zcol = ZKB + 64 * (s - 12); rope = true; nrm = true; g = p.kn_g + l * 64; }
            else if (s < 20) { zcol = ZQN + 64 * (s - 16); isq = true; }
            else if (s < 24) { zcol = ZKN + 64 * (s - 20); }
            else if (s < 32) { zcol = ZXR + 64 * (s - 28); }
            else { zcol = ZXG + 64 * (s - 32); }
            const bool latent = jt >= LC;
            bf16* stg = lds + wave * (64 * GP);
#pragma unroll
            for (int mi = 0; mi < 4; ++mi) {
                const int j = jt + wm * 64 + mi * 16 + l15;
                float v[4][4];
#pragma unroll
                for (int nj = 0; nj < 4; ++nj)
#pragma unroll
                    for (int q = 0; q < 4; ++q) v[nj][q] = acc[mi][nj][q];
                if (nrm) {
                    float ss = 0.f;
#pragma unroll
                    for (int nj = 0; nj < 4; ++nj)
#pragma unroll
                        for (int q = 0; q < 4; ++q) ss += v[nj][q] * v[nj][q];
                    ss += __shfl_xor(ss, 16); ss += __shfl_xor(ss, 32);
                    const float rstd = rsqrtf(ss * (1.f / 64.f) + EPS);
#pragma unroll
                    for (int nj = 0; nj < 4; ++nj) {
                        const float4 g4 = *(const float4*)(g + nj * 16 + gq * 4);
                        v[nj][0] *= rstd * g4.x; v[nj][1] *= rstd * g4.y; v[nj][2] *= rstd * g4.z; v[nj][3] *= rstd * g4.w;
                    }
                }
                if (rope && latent) {
                    const int t = j - LC, pr = t >> 6, pc = t & 63;
                    const float4* r1 = (const float4*)(rt + pr * 16 + gq * 4);
                    const float4* r2 = (const float4*)(rt + pc * 16 + gq * 4);
                    const float4 a0 = r1[0], a1 = r1[1], b0 = r2[0], b1 = r2[1];
                    const float cs1[4][2] = {{a0.x, a0.y}, {a0.z, a0.w}, {a1.x, a1.y}, {a1.z, a1.w}};
                    const float cs2[4][2] = {{b0.x, b0.y}, {b0.z, b0.w}, {b1.x, b1.y}, {b1.z, b1.w}};
#pragma unroll
                    for (int q = 0; q < 4; ++q) {
                        const float x1 = v[0][q], x2 = v[1][q], y1 = v[2][q], y2 = v[3][q];
                        v[0][q] = x1 * cs1[q][0] - x2 * cs1[q][1]; v[1][q] = x1 * cs1[q][1] + x2 * cs1[q][0];
                        v[2][q] = y1 * cs2[q][0] - y2 * cs2[q][1]; v[3][q] = y1 * cs2[q][1] + y2 * cs2[q][0];
                    }
                }
                const float sc = isq ? (nrm ? 0.125f * 1.4426950408889634f : 0.125f) : 1.f;
#pragma unroll
                for (int nj = 0; nj < 4; ++nj) {
                    uint2 w; w.x = pk2(v[nj][0] * sc, v[nj][1] * sc); w.y = pk2(v[nj][2] * sc, v[nj][3] * sc);
                    *(uint2*)(stg + (mi * 16 + l15) * GP + nj * 16 + gq * 4) = w;
                }
            }
            {
                const size_t r0 = (size_t)bb * TB + jt + wm * 64;
#pragma unroll
                for (int it = 0; it < 8; ++it) {
                    const int rs = it * 8 + (lane >> 3), ch = lane & 7;
                    *(u4v*)(Z + (r0 + rs) * ZP + zcol + ch * 8) = *(const u4v*)(stg + rs * GP + ch * 8);
                }
            }
        }
        __syncthreads();
    }
}

__device__ __forceinline__ void phase_outproj_fast(const Params& p, int l, bf16* lds) {
    const int tid = tid_op(), lane = tid & 63, wave = tid >> 6, wm = wave >> 1, wn = wave & 1, l15 = lane & 15, gq = lane >> 4;
    const bf16* Y = (const bf16*)(p.ws + WS_Y);
    const bf16* W = (const bf16*)(p.ws + WS_WOUT) + (size_t)l * D * D;
    const float* modv = (const float*)(p.ws + WS_MOD);
    for (int tile = blockIdx.x; tile < 264 * 8; tile += gridDim.x) {
        const int mt = tile >> 3, nt = tile & 7;
        const int bb = mt / 66, jt = (mt - bb * 66) * 128;
        if (l == 1 && jt < LC) continue;
        f4v acc[4][4];
#pragma unroll
        for (int i = 0; i < 4; ++i)
#pragma unroll
            for (int j = 0; j < 4; ++j) acc[i][j] = (f4v){0.f, 0.f, 0.f, 0.f};
        gemm_mainloop<true>(Y + (size_t)mt * 128 * D, W + (size_t)nt * 128 * D, lds, acc);
        const float* gtv = modv + ((size_t)l * 5 + (jt < LC ? 4 : bb)) * 6144 + 2048;
#pragma unroll
        for (int mi = 0; mi < 4; ++mi) {
            const int r = bb * TB + jt + wm * 64 + mi * 16 + l15;
            const float* xin = (l == 0) ? in_row(p, r) : xs_row(p, r);
            float* xo = xs_row(p, r);
#pragma unroll
            for (int nj = 0; nj < 4; ++nj) {
                const int col = nt * 128 + wn * 64 + nj * 16 + gq * 4;
                const float4 xi = *(const float4*)(xin + col), gt = *(const float4*)(gtv + col);
                *(float4*)(xo + col) = make_float4(xi.x + gt.x * acc[mi][nj][0], xi.y + gt.y * acc[mi][nj][1], xi.z + gt.z * acc[mi][nj][2], xi.w + gt.w * acc[mi][nj][3]);
            }
        }
    }
}


__device__ __forceinline__ void ce_desc(unsigned& a, unsigned& b) { const unsigned hi = max(a, b), lo = min(a, b); a = hi; b = lo; }
__device__ __forceinline__ void bitonic_merge16(unsigned (&v)[16]) {
#pragma unroll
    for (int j = 8; j > 0; j >>= 1)
#pragma unroll
        for (int i = 0; i < 16; ++i) { const int l = i ^ j; if (l > i) ce_desc(v[i], v[l]); }
}
__device__ __forceinline__ void bitonic_sort16(unsigned (&v)[16]) {
#pragma unroll
    for (int k = 2; k <= 16; k <<= 1)
#pragma unroll
        for (int j = k >> 1; j > 0; j >>= 1)
#pragma unroll
            for (int i = 0; i < 16; ++i) {
                const int l = i ^ j;
                if (l > i) { if ((i & k) == 0 || k == 16) ce_desc(v[i], v[l]); else ce_desc(v[l], v[i]); }
            }
}
__device__ __forceinline__ unsigned f2ord(float f) { unsigned u = __float_as_uint(f); return (u & 0x80000000u) ? ~u : (u | 0x80000000u); }
__device__ __forceinline__ void phase_peerq_fast(const Params& p, int l, bf16* lds) {
    const int tid = tid_op(), lane = tid & 63, wave = tid >> 6, wm = wave >> 1, wn = wave & 1, l15 = lane & 15, gq = lane >> 4;
    const bf16* H = (const bf16*)(p.ws + WS_H);
    const bf16* W = (const bf16*)(p.ws + WS_WQ) + (size_t)l * 2048 * D;
    const bf16* KY = (const bf16*)(p.ws + WS_KEYS) + (size_t)l * 2 * 128 * 128;
    float* stop = (float*)(p.ws + WS_STOP);
    unsigned char* itop = p.ws + WS_ITOP;
    constexpr int QP = 136, SP = 132;
    bf16* Qs = lds; bf16* Ks = lds + 128 * QP;
    float* Sf = (float*)lds;
    for (int tile = blockIdx.x; tile < 264 * 16; tile += gridDim.x) {
        const int mt = tile >> 4, hp = tile & 15;
        const int bb = mt / 66, jt = (mt - bb * 66) * 128;
        if (l == 1 && jt < LC) continue;
        f4v acc[4][4];
#pragma unroll
        for (int i = 0; i < 4; ++i)
#pragma unroll
            for (int j = 0; j < 4; ++j) acc[i][j] = (f4v){0.f, 0.f, 0.f, 0.f};
        u4v kreg[8];
        {
            const bf16* kg = KY + (size_t)(hp & 1) * 128 * 128;
#pragma unroll
            for (int i = 0; i < 8; ++i) { int c = tid + i * 256, row = c >> 4, kc = c & 15; kreg[i] = *(const u4v*)(kg + row * 128 + kc * 8); }
        }
        gemm_mainloop<true>(H + (size_t)mt * 128 * D, W + (size_t)hp * 128 * D, lds, acc);
#pragma unroll
        for (int mi = 0; mi < 4; ++mi)
#pragma unroll
            for (int nj = 0; nj < 4; ++nj) {
                uint2 w; w.x = pk2(acc[mi][nj][0], acc[mi][nj][1]); w.y = pk2(acc[mi][nj][2], acc[mi][nj][3]);
                *(uint2*)(Qs + (wm * 64 + mi * 16 + l15) * QP + wn * 64 + nj * 16 + gq * 4) = w;
            }
#pragma unroll
        for (int i = 0; i < 8; ++i) { int c = tid + i * 256, row = c >> 4, kc = c & 15; *(u4v*)(Ks + row * QP + kc * 8) = kreg[i]; }
        __syncthreads();
        f4v a2[2][8];
#pragma unroll
        for (int i = 0; i < 2; ++i)
#pragma unroll
            for (int j = 0; j < 8; ++j) a2[i][j] = (f4v){0.f, 0.f, 0.f, 0.f};
#pragma unroll
        for (int ks = 0; ks < 4; ++ks) {
            s8v af[2], bfr[8];
#pragma unroll
            for (int i = 0; i < 2; ++i) af[i] = *(const s8v*)(Qs + (wave * 32 + i * 16 + l15) * QP + ks * 32 + gq * 8);
#pragma unroll
            for (int j = 0; j < 8; ++j) bfr[j] = *(const s8v*)(Ks + (j * 16 + l15) * QP + ks * 32 + gq * 8);
            __builtin_amdgcn_s_setprio(1);
#pragma unroll
            for (int i = 0; i < 2; ++i)
#pragma unroll
                for (int j = 0; j < 8; ++j) a2[i][j] = MFMA16(bfr[j], af[i], a2[i][j]);
            __builtin_amdgcn_s_setprio(0);
        }
        __syncthreads();
#pragma unroll
        for (int i = 0; i < 2; ++i)
#pragma unroll
            for (int j = 0; j < 8; ++j) *(f4v*)(Sf + (wave * 32 + i * 16 + l15) * SP + j * 16 + gq * 4) = a2[i][j];
        __syncthreads();
        {
            const int row = tid >> 1, half = tid & 1;
            const float* sr = Sf + row * SP;
            unsigned L[16];
#pragma unroll
            for (int ch = 0; ch < 4; ++ch) {
                unsigned C[16];
#pragma unroll
                for (int i4 = 0; i4 < 4; ++i4) {
                    const int col = half * 64 + ch * 16 + i4 * 4;
                    const f4v s4 = *(const f4v*)(sr + col);
#pragma unroll
                    for (int q = 0; q < 4; ++q) C[i4 * 4 + q] = (f2ord(s4[q]) & ~127u) | (unsigned)(col + q);
                }
                bitonic_sort16(C);
                if (ch == 0) {
#pragma unroll
                    for (int i = 0; i < 16; ++i) L[i] = C[i];
                } else {
#pragma unroll
                    for (int i = 0; i < 16; ++i) L[i] = max(L[i], C[15 - i]);
                    bitonic_merge16(L);
                }
            }
            {
                unsigned Pn[16];
#pragma unroll
                for (int i = 0; i < 16; ++i) Pn[i] = __shfl_xor(L[i], 1);
#pragma unroll
                for (int i = 0; i < 16; ++i) L[i] = max(L[i], Pn[15 - i]);
                bitonic_merge16(L);
            }
            if (half == 0) {
                const size_t r = (size_t)bb * TB + jt + row;
                float sv[16];
#pragma unroll
                for (int i = 0; i < 16; ++i) sv[i] = sr[L[i] & 127u];
                float* so = stop + (r * 16 + hp) * 16;
#pragma unroll
                for (int i = 0; i < 4; ++i) *(float4*)(so + i * 4) = make_float4(sv[i * 4], sv[i * 4 + 1], sv[i * 4 + 2], sv[i * 4 + 3]);
                u4v iw;
#pragma unroll
                for (int i = 0; i < 4; ++i) iw[i] = (L[i * 4] & 127u) | ((L[i * 4 + 1] & 127u) << 8) | ((L[i * 4 + 2] & 127u) << 16) | ((L[i * 4 + 3] & 127u) << 24);
                *(u4v*)(itop + (r * 16 + hp) * 16) = iw;
            }
        }
        __syncthreads();
    }
}


__device__ __forceinline__ unsigned cvtpk(float lo, float hi) { f32x2_t v = {lo, hi}; return __builtin_bit_cast(unsigned, __builtin_convertvector(v, bf16x2_t)); }
__device__ __forceinline__ float max3f(float a, float b, float c) { float r; asm("v_max3_f32 %0, %1, %2, %3" : "=v"(r) : "v"(a), "v"(b), "v"(c)); return r; }
constexpr int ATL = 64 * GP;
constexpr int BIAS_OFF_B = 66048, LRUW_OFF_B = 49152;

template <int KIND>
__device__ __forceinline__ void attn_item_fast(const Params& p, int l, int b, int hsel, int blk, bool ctxq, bf16* lds, const float* biasLds) {
    constexpr int kind = KIND;
    const int tid = tid_op(), lane = tid & 63, wave = __builtin_amdgcn_readfirstlane(tid >> 6), l15 = lane & 15, gq = lane >> 4;
    const bf16* Z = (const bf16*)(p.ws + WS_Z) + (size_t)b * TB * ZP;
    int head, j0;
    if (kind == 2) { head = hsel; j0 = ctxq ? wave * 64 : LC + (blk * 4 + wave) * 64; }
    else { head = hsel * 2 + (wave >> 1); j0 = (ctxq ? 0 : LC) + blk * 128 + (wave & 1) * 64; }
    const int kvh = (kind == 2) ? head : hsel;
    const int qcol = (kind == 0 ? ZQA : kind == 1 ? ZQB : ZQN) + head * 64;
    const int kcol = (kind == 0 ? ZKA : kind == 1 ? ZKB : ZKN) + kvh * 64;
    const bf16* Vg = (kind == 0) ? (const bf16*)(p.ws + WS_VTA) + ((size_t)(b * 2 + kvh) * 64) * TB
                   : (kind == 1) ? (const bf16*)(p.ws + WS_VTB) + ((size_t)(b * 2 + kvh) * 64) * TB
                                 : (const bf16*)(p.ws + WS_VTN) + ((size_t)(b * 4 + kvh) * 64) * TB;
    const bf16* Kg = Z + kcol;
    s8v qf[4][2];
#pragma unroll
    for (int nt = 0; nt < 4; ++nt)
#pragma unroll
        for (int ks = 0; ks < 2; ++ks) qf[nt][ks] = *(const s8v*)(Z + (size_t)(j0 + nt * 16 + l15) * ZP + qcol + ks * 32 + gq * 8);
#pragma unroll
    for (int nt = 0; nt < 4; ++nt)
#pragma unroll
        for (int ks = 0; ks < 2; ++ks) asm volatile("" : "+v"(qf[nt][ks]));
    int ntile = 4, locbase = 0;
    if (!ctxq) {
        if (kind == 1) { ntile = 132; }
        else if (kind == 0) { int lo = (blk - 1) * 128, hi = (blk + 2) * 128; lo = lo < 0 ? 0 : lo; hi = hi > SEQ ? SEQ : hi; ntile = 4 + ((hi - lo) >> 6); locbase = LC + lo; }
        else { int lo = blk * 4 - 4; lo = lo < 0 ? 0 : (lo > 120 ? 120 : lo); int hi = blk * 4 + 3 - 4; hi = hi < 0 ? 0 : (hi > 120 ? 120 : hi); hi += 7; ntile = 4 + (hi - lo + 1); locbase = LC + lo * 64; }
    }
    const int qt0 = j0 - LC;
    int kr0w = (qt0 >> 6) - 4; kr0w = kr0w < 0 ? 0 : (kr0w > 120 ? 120 : kr0w);
    f4v ot[4][4];
    float mrun[4], ls[4];
#pragma unroll
    for (int i = 0; i < 4; ++i) {
        mrun[i] = -1e30f; ls[i] = 0.f;
#pragma unroll
        for (int j = 0; j < 4; ++j) ot[i][j] = (f4v){0.f, 0.f, 0.f, 0.f};
    }
    float negc = 0.f;
    if (KIND == 1) {
        const float gqm = wave_max(fabsf(p.qn_g[l * 64 + lane])), gkm = wave_max(fabsf(p.kn_g[l * 64 + lane]));
        negc = -8.f * gqm * gkm * 1.0002f * 1.4426950408889634f;
    }
    const int lr = tid >> 3, lc = tid & 7;
    const int vpos = (lc >> 2) * 32 + (lc & 1) * 16 + ((lc >> 1) & 1) * 4;
    u4v rk[2], rv[2];
    {
        const int kb0 = 0;
#pragma unroll
        for (int c = 0; c < 2; ++c) {
            rk[c] = *(const u4v*)(Kg + (size_t)(kb0 + lr + 32 * c) * ZP + lc * 8);
            rv[c] = *(const u4v*)(Vg + (size_t)(lr + 32 * c) * TB + kb0 + lc * 8);
        }
#pragma unroll
        for (int c = 0; c < 2; ++c) {
            *(u4v*)(lds + (lr + 32 * c) * GP + lc * 8) = rk[c];
            bf16* vd = lds + ATL + (lr + 32 * c) * GP + vpos;
            *(uint2*)vd = make_uint2(rv[c][0], rv[c][1]); *(uint2*)(vd + 8) = make_uint2(rv[c][2], rv[c][3]);
        }
    }
    __syncthreads();
#pragma unroll 1
    for (int i = 0; i < ntile; ++i) {
        const int buf = i & 1;
        if (i + 1 < ntile) {
            const int kb1 = (kind == 1 || ctxq || i + 1 < 4) ? (i + 1) * 64 : locbase + (i + 1 - 4) * 64;
#pragma unroll
            for (int c = 0; c < 2; ++c) {
                rk[c] = *(const u4v*)(Kg + (size_t)(kb1 + lr + 32 * c) * ZP + lc * 8);
                rv[c] = *(const u4v*)(Vg + (size_t)(lr + 32 * c) * TB + kb1 + lc * 8);
            }
        }
        bool use = true; int maskmode = 0; int tt0 = 0, krow = 0;
        if (!ctxq && i >= 4) {
            if (kind == 0) { tt0 = locbase - LC + (i - 4) * 64; use = (tt0 + 63 >= qt0 - 128) && (tt0 <= qt0 + 63 + 128); maskmode = 1; }
            else if (kind == 2) { krow = ((locbase - LC) >> 6) + (i - 4); use = (krow >= kr0w) && (krow < kr0w + 8); maskmode = 2; }
        }
        if (use) {
            const bf16* Ks = lds + buf * 2 * ATL;
            const bf16* Vs = Ks + ATL;
            const float* bt = biasLds + head * 465 + (krow - (qt0 >> 6) + 7) * 31 + 15;
#pragma unroll 1
            for (int hk = 0; hk < 2; ++hk) {
                f4v st[2][4];
#pragma unroll
                for (int a = 0; a < 2; ++a)
#pragma unroll
                    for (int c = 0; c < 4; ++c) st[a][c] = (f4v){negc, negc, negc, negc};
#pragma unroll
                for (int ks = 0; ks < 2; ++ks) {
                    s8v kf[2];
#pragma unroll
                    for (int mt = 0; mt < 2; ++mt) kf[mt] = *(const s8v*)(Ks + ((hk * 2 + mt) * 16 + l15) * GP + ks * 32 + gq * 8);
                    __builtin_amdgcn_s_setprio(1);
#pragma unroll
                    for (int mt = 0; mt < 2; ++mt)
#pragma unroll
                        for (int nt = 0; nt < 4; ++nt) st[mt][nt] = MFMA16(kf[mt], qf[nt][ks], st[mt][nt]);
                    __builtin_amdgcn_s_setprio(0);
                }
                if (maskmode == 1) {
#pragma unroll
                    for (int nt = 0; nt < 4; ++nt) {
                        const int qt = qt0 + nt * 16 + l15;
#pragma unroll
                        for (int mt = 0; mt < 2; ++mt)
#pragma unroll
                            for (int q = 0; q < 4; ++q) { int dl = tt0 + (hk * 2 + mt) * 16 + gq * 4 + q - qt; if (dl > 128 || dl < -128) st[mt][nt][q] = -1e30f; }
                    }
                } else if (maskmode == 2) {
#pragma unroll
                    for (int nt = 0; nt < 4; ++nt) {
                        const int qc = nt * 16 + l15;
                        int cs0 = qc - 8; cs0 = cs0 < 0 ? 0 : (cs0 > 48 ? 48 : cs0);
#pragma unroll
                        for (int mt = 0; mt < 2; ++mt)
#pragma unroll
                            for (int q = 0; q < 4; ++q) {
                                const int kc = (hk * 2 + mt) * 16 + gq * 4 + q;
                                int dc = kc - qc; dc = dc < -15 ? -15 : (dc > 15 ? 15 : dc);
                                const bool ok = (kc >= cs0) && (kc < cs0 + 16);
                                st[mt][nt][q] = ok ? st[mt][nt][q] + bt[dc] : -1e30f;
                            }
                    }
                }
                s8v pf[4];
#pragma unroll
                for (int nt = 0; nt < 4; ++nt) {
                    float psum = 0.f;
                    if (KIND == 1) {
#pragma unroll
                        for (int mt = 0; mt < 2; ++mt)
#pragma unroll
                            for (int q = 0; q < 4; ++q) { float pv = __builtin_amdgcn_exp2f(st[mt][nt][q]); st[mt][nt][q] = pv; psum += pv; }
                    } else {
                        float mx = max3f(max3f(st[0][nt][0], st[0][nt][1], st[0][nt][2]), max3f(st[0][nt][3], st[1][nt][0], st[1][nt][1]), max3f(st[1][nt][2], st[1][nt][3], mrun[nt]));
                        mx = max3f(mx, __shfl_xor(mx, 16), mx); mx = max3f(mx, __shfl_xor(mx, 32), mx);
                        if (__any(mx > mrun[nt] + 8.f)) {
                            const float mnew = fmaxf(mrun[nt], mx);
                            const float alpha = __expf(mrun[nt] - mnew);
                            mrun[nt] = mnew;
                            ls[nt] *= alpha;
#pragma unroll
                            for (int dt = 0; dt < 4; ++dt) ot[dt][nt] *= alpha;
                        }
                        const float mcur = mrun[nt];
#pragma unroll
                        for (int mt = 0; mt < 2; ++mt)
#pragma unroll
                            for (int q = 0; q < 4; ++q) { float pv = __expf(st[mt][nt][q] - mcur); st[mt][nt][q] = pv; psum += pv; }
                    }
                    ls[nt] += psum;
                    u4v w;
                    w[0] = cvtpk(st[0][nt][0], st[0][nt][1]); w[1] = cvtpk(st[0][nt][2], st[0][nt][3]);
                    w[2] = cvtpk(st[1][nt][0], st[1][nt][1]); w[3] = cvtpk(st[1][nt][2], st[1][nt][3]);
                    pf[nt] = __builtin_bit_cast(s8v, w);
                }
                s8v vf[4];
#pragma unroll
                for (int dt = 0; dt < 4; ++dt) {
                    vf[dt] = *(const s8v*)(Vs + (dt * 16 + l15) * GP + hk * 32 + gq * 8);
                }
                __builtin_amdgcn_s_setprio(1);
#pragma unroll
                for (int dt = 0; dt < 4; ++dt)
#pragma unroll
                    for (int nt = 0; nt < 4; ++nt) ot[dt][nt] = MFMA16(vf[dt], pf[nt], ot[dt][nt]);
                __builtin_amdgcn_s_setprio(0);
            }
        }
        if (i + 1 < ntile) {
            bf16* kd = lds + (buf ^ 1) * 2 * ATL;
#pragma unroll
            for (int c = 0; c < 2; ++c) {
                *(u4v*)(kd + (lr + 32 * c) * GP + lc * 8) = rk[c];
                bf16* vd = kd + ATL + (lr + 32 * c) * GP + vpos;
                *(uint2*)vd = make_uint2(rv[c][0], rv[c][1]); *(uint2*)(vd + 8) = make_uint2(rv[c][2], rv[c][3]);
            }
        }
        __syncthreads();
    }
    const float sk = (kind == 0) ? p.attn_sink[l * 4 + head] : 0.f;
#pragma unroll
    for (int nt = 0; nt < 4; ++nt) {
        float lsum = ls[nt];
        lsum += __shfl_xor(lsum, 16); lsum += __shfl_xor(lsum, 32);
        float scale = 1.f;
        if (kind == 0) { const float mx = fmaxf(mrun[nt], sk), a = __expf(mrun[nt] - mx); lsum = lsum * a + __expf(sk - mx); scale = a; }
        const float inv = scale / lsum;
        bf16* y = (bf16*)(p.ws + WS_Y) + ((size_t)b * TB + j0 + nt * 16 + l15) * D + kind * 256 + head * 64;
#pragma unroll
        for (int dt = 0; dt < 4; ++dt) {
            uint2 w; w.x = cvtpk(ot[dt][nt][0] * inv, ot[dt][nt][1] * inv); w.y = cvtpk(ot[dt][nt][2] * inv, ot[dt][nt][3] * inv);
            *(uint2*)(y + dt * 16 + gq * 4) = w;
        }
    }
}


constexpr int LX_OFF = 0, LU_OFF = 8704, LA_OFF = 17920, LB_OFF = 34304, LCW_OFF = 50688, LWX_OFF = 51968;
template <int STP>
__device__ __forceinline__ void seg_aggr(const float* Aa, const float* Bb, int a0, float& ap, float& hl) {
#pragma unroll
    for (int half = 0; half < 2; ++half) {
        float av[8], bv[8];
#pragma unroll
        for (int i = 0; i < 8; ++i) { av[i] = Aa[a0 + (half * 8 + i) * STP]; bv[i] = Bb[a0 + (half * 8 + i) * STP]; }
#pragma unroll
        for (int i = 0; i < 8; ++i) { hl = av[i] * hl + bv[i]; ap *= av[i]; }
    }
}
template <int STP>
__device__ __forceinline__ void seg_apply(float* Aa, float* Bb, int a0, float hin, float ain) {
#pragma unroll
    for (int half = 0; half < 2; ++half) {
        float av[8], bv[8];
#pragma unroll
        for (int i = 0; i < 8; ++i) { av[i] = Aa[a0 + (half * 8 + i) * STP]; bv[i] = Bb[a0 + (half * 8 + i) * STP]; }
#pragma unroll
        for (int i = 0; i < 8; ++i) { hin = av[i] * hin + bv[i]; ain *= av[i]; av[i] = hin; bv[i] = ain; }
#pragma unroll
        for (int i = 0; i < 8; ++i) { Aa[a0 + (half * 8 + i) * STP] = av[i]; Bb[a0 + (half * 8 + i) * STP] = bv[i]; }
    }
}
constexpr int LRU_NSEG = 6, LRU_SEGC = 22;
constexpr int LRU_ITEMS = 16 * 2 * LRU_NSEG;
__device__ __forceinline__ void lru_item_fast(const Params& p, int l, int b, int n, int dir, int seg, unsigned char* smem) {
    const int tid = tid_op(), lane = tid & 63, wave = __builtin_amdgcn_readfirstlane(tid >> 6), l15 = lane & 15, gq = lane >> 4;
    bf16* Xs = (bf16*)(smem + LX_OFF);
    bf16* Us = (bf16*)(smem + LU_OFF);
    float* Aa = (float*)(smem + LA_OFF);
    float* Bb = (float*)(smem + LB_OFF);
    float* CW = (float*)(smem + LCW_OFF);
    float* SAg = (float*)(smem + LWX_OFF + 9216);
    float* SBg = SAg + 256;
    bf16* WXs = (bf16*)(smem + LWX_OFF);
    const bf16* Z = (const bf16*)(p.ws + WS_Z) + (size_t)b * TB * ZP;
    float* HL = (float*)(p.ws + (dir ? WS_H : WS_HF)) + ((size_t)b * TB) * 256 + n * 64;
    float* AC = HL + (size_t)M * 256;
    for (int i = tid; i < 320; i += 256) { int q = i >> 6, c = i & 63; CW[i] = (q < 4) ? p.conv_w[(l * 4 + q) * 256 + n * 64 + c] : p.conv_b[l * 256 + n * 64 + c]; }
    const int ptok = tid >> 2, ppart = tid & 3;
    const int lr = tid >> 3, lc = tid & 7;
    const bf16* wbase = (const bf16*)(p.ws + WS_LRUW) + ((size_t)((l * 2 + dir) * 2) * 4 + n) * 4096;
    s8v wfa[4][2];
#pragma unroll
    for (int nj = 0; nj < 4; ++nj)
#pragma unroll
        for (int ks = 0; ks < 2; ++ks) wfa[nj][ks] = *(const s8v*)(wbase + (nj * 16 + l15) * 64 + ks * 32 + gq * 8);
#pragma unroll
    for (int i = 0; i < 2; ++i) { int cidx = tid + i * 256, row = cidx >> 3, kc = cidx & 7; *(u4v*)(WXs + row * GP + kc * 8) = *(const u4v*)(wbase + (size_t)4 * 4096 + row * 64 + kc * 8); }
    float cba[4], cbx[4], csp[4];
#pragma unroll
    for (int nj = 0; nj < 4; ++nj) {
        const int ch = n * 64 + nj * 16 + l15;
        cba[nj] = p.lru_ba[(l * 2 + dir) * 256 + ch]; cbx[nj] = p.lru_bx[(l * 2 + dir) * 256 + ch];
        const float lam = p.lru_lam[(l * 2 + dir) * 256 + ch];
        csp[nj] = (lam > 15.f) ? __expf(-lam) : log1pf(__expf(-lam));
    }
#pragma unroll
    for (int nj = 0; nj < 4; ++nj) {
#pragma unroll
        for (int ks = 0; ks < 2; ++ks) asm volatile("" : "+v"(wfa[nj][ks]));
        asm volatile("" : "+v"(cba[nj]), "+v"(cbx[nj]), "+v"(csp[nj]));
    }
    float h = 0.f, ain = 1.f;
    u4v rx[3];
    const int cbeg = seg * LRU_SEGC;
    {
        const int c = cbeg;
        const int jlo = dir ? (c < 4 ? LC - 64 - c * 64 : TB + LC - 64 - c * 64) : c * 64;
        const int lo = (jlo < LC) ? 0 : LC, hi = (jlo < LC) ? LC : TB;
#pragma unroll
        for (int i = 0; i < 3; ++i) { int row = lr + 32 * i, jj = jlo - 2 + row; rx[i] = (row < 67 && jj >= lo && jj < hi) ? *(const u4v*)(Z + (size_t)jj * ZP + ZXR + n * 64 + lc * 8) : (u4v){0u, 0u, 0u, 0u}; }
#pragma unroll
        for (int i = 0; i < 3; ++i) if (lr + 32 * i < 68) *(u4v*)(Xs + (lr + 32 * i) * 64 + lc * 8) = rx[i];
    }
#pragma unroll 1
    for (int c = cbeg; c < cbeg + LRU_SEGC; ++c) {
        const int jlo = dir ? (c < 4 ? LC - 64 - c * 64 : TB + LC - 64 - c * 64) : c * 64;
        if (c + 1 < cbeg + LRU_SEGC) {
            const int c1 = c + 1;
            const int jn = dir ? (c1 < 4 ? LC - 64 - c1 * 64 : TB + LC - 64 - c1 * 64) : c1 * 64;
            const int lo = (jn < LC) ? 0 : LC, hi = (jn < LC) ? LC : TB;
#pragma unroll
            for (int i = 0; i < 3; ++i) { int row = lr + 32 * i, jj = jn - 2 + row; rx[i] = (row < 67 && jj >= lo && jj < hi) ? *(const u4v*)(Z + (size_t)jj * ZP + ZXR + n * 64 + lc * 8) : (u4v){0u, 0u, 0u, 0u}; }
        }
        lds_barrier();
        {
            float u[16];
#pragma unroll
            for (int i = 0; i < 16; ++i) u[i] = CW[256 + ppart * 16 + i];
#pragma unroll
            for (int q = 0; q < 4; ++q) {
                const u4v x0 = *(const u4v*)(Xs + (ptok + q) * 64 + ppart * 16), x1 = *(const u4v*)(Xs + (ptok + q) * 64 + ppart * 16 + 8);
#pragma unroll
                for (int i = 0; i < 4; ++i) {
                    u[2 * i] += CW[q * 64 + ppart * 16 + 2 * i] * lo16(x0[i]); u[2 * i + 1] += CW[q * 64 + ppart * 16 + 2 * i + 1] * hi16(x0[i]);
                    u[8 + 2 * i] += CW[q * 64 + ppart * 16 + 8 + 2 * i] * lo16(x1[i]); u[8 + 2 * i + 1] += CW[q * 64 + ppart * 16 + 8 + 2 * i + 1] * hi16(x1[i]);
                }
            }
            u4v w0, w1;
#pragma unroll
            for (int i = 0; i < 4; ++i) { w0[i] = pk2(u[2 * i], u[2 * i + 1]); w1[i] = pk2(u[8 + 2 * i], u[8 + 2 * i + 1]); }
            *(u4v*)(Us + ptok * GP + ppart * 16) = w0; *(u4v*)(Us + ptok * GP + ppart * 16 + 8) = w1;
        }
        lds_barrier();
        {
            f4v ga[4], gx[4];
#pragma unroll
            for (int nj = 0; nj < 4; ++nj) { ga[nj] = (f4v){0.f, 0.f, 0.f, 0.f}; gx[nj] = (f4v){0.f, 0.f, 0.f, 0.f}; }
#pragma unroll
            for (int ks = 0; ks < 2; ++ks) {
                const s8v af = *(const s8v*)(Us + (wave * 16 + l15) * GP + ks * 32 + gq * 8);
                s8v wx[4];
#pragma unroll
                for (int nj = 0; nj < 4; ++nj) wx[nj] = *(const s8v*)(WXs + (nj * 16 + l15) * GP + ks * 32 + gq * 8);
                __builtin_amdgcn_s_setprio(1);
#pragma unroll
                for (int nj = 0; nj < 4; ++nj) { ga[nj] = MFMA16(af, wfa[nj][ks], ga[nj]); gx[nj] = MFMA16(af, wx[nj], gx[nj]); }
                __builtin_amdgcn_s_setprio(0);
            }
#pragma unroll
            for (int nj = 0; nj < 4; ++nj)
#pragma unroll
                for (int q = 0; q < 4; ++q) {
                    const int tok = wave * 16 + gq * 4 + q, ch = nj * 16 + l15;
                    const float uu = bf2f(Us[tok * GP + ch]);
                    const float rg = __builtin_amdgcn_rcpf(1.f + __expf(-(ga[nj][q] + cba[nj]))), ig = __builtin_amdgcn_rcpf(1.f + __expf(-(gx[nj][q] + cbx[nj])));
                    const float av_ = __expf(-8.f * rg * csp[nj]);
                    Aa[tok * 64 + ch] = av_;
                    Bb[tok * 64 + ch] = __builtin_amdgcn_sqrtf(fmaxf(1.f - av_ * av_, 0.f)) * (ig * uu);
                }
        }
        lds_barrier();
        {
            const int tb = dir ? (63 - wave * 16) : wave * 16;
            const int a0 = tb * 64 + lane;
            float ap = 1.f, hl = 0.f;
            if (dir) seg_aggr<-64>(Aa, Bb, a0, ap, hl); else seg_aggr<64>(Aa, Bb, a0, ap, hl);
            SAg[wave * 64 + lane] = ap; SBg[wave * 64 + lane] = hl;
            lds_barrier();
            float hin = h, ainw = ain, hc = h, ac = ain;
#pragma unroll
            for (int w2 = 0; w2 < 4; ++w2) { if (w2 == wave) { hin = hc; ainw = ac; } const float sa = SAg[w2 * 64 + lane]; hc = sa * hc + SBg[w2 * 64 + lane]; ac *= sa; }
            h = hc; ain = ac;
            if (dir) seg_apply<-64>(Aa, Bb, a0, hin, ainw); else seg_apply<64>(Aa, Bb, a0, hin, ainw);
        }
        lds_barrier();
        {
#pragma unroll
            for (int i = 0; i < 4; ++i) {
                *(f4v*)(HL + (size_t)(jlo + ptok) * 256 + ppart * 16 + i * 4) = *(const f4v*)(Aa + ptok * 64 + ppart * 16 + i * 4);
                *(f4v*)(AC + (size_t)(jlo + ptok) * 256 + ppart * 16 + i * 4) = *(const f4v*)(Bb + ptok * 64 + ppart * 16 + i * 4);
            }
        }
        if (c + 1 < cbeg + LRU_SEGC) {
#pragma unroll
            for (int i = 0; i < 3; ++i) if (lr + 32 * i < 68) *(u4v*)(Xs + (lr + 32 * i) * 64 + lc * 8) = rx[i];
        }
    }
    if (wave == 0) {
        float* ag = (float*)(p.ws + WS_AGG) + ((size_t)(((b * 4 + n) * 2 + dir) * LRU_NSEG + seg)) * 128;
        ag[lane] = h; ag[64 + lane] = ain;
    }
    lds_barrier();
}

__device__ __forceinline__ void phase_lru_combine(const Params& p, int l) {
    const int tid = tid_op();
    const float* HLb = (const float*)(p.ws + WS_HF);
    const float* HLb1 = (const float*)(p.ws + WS_H);
    const float* AG = (const float*)(p.ws + WS_AGG);
    const bf16* Zb = (const bf16*)(p.ws + WS_Z);
    bf16* Yb = (bf16*)(p.ws + WS_Y);
    for (int u = blockIdx.x * 256 + tid; u < M * 32; u += gridDim.x * 256) {
        const int r = u >> 5, g = u & 31, b = r / TB, j = r - b * TB;
        if (l == 1 && j < LC) continue;
        const int ch0 = g * 8, n = ch0 >> 6, cl = ch0 & 63;
        const int seg0 = (j >> 6) / LRU_SEGC;
        const int c1 = (j < LC) ? 3 - (j >> 6) : 135 - (j >> 6);
        const int seg1 = c1 / LRU_SEGC;
        float car0[8], car1[8];
#pragma unroll
        for (int i = 0; i < 8; ++i) { car0[i] = 0.f; car1[i] = 0.f; }
        for (int s = 0; s < seg0; ++s) {
            const float* ag = AG + ((size_t)(((b * 4 + n) * 2 + 0) * LRU_NSEG + s)) * 128 + cl;
#pragma unroll
            for (int i = 0; i < 8; ++i) car0[i] = ag[64 + i] * car0[i] + ag[i];
        }
        for (int s = 0; s < seg1; ++s) {
            const float* ag = AG + ((size_t)(((b * 4 + n) * 2 + 1) * LRU_NSEG + s)) * 128 + cl;
#pragma unroll
            for (int i = 0; i < 8; ++i) car1[i] = ag[64 + i] * car1[i] + ag[i];
        }
        const size_t ro = (size_t)r * 256 + ch0;
        const f4v h0a = *(const f4v*)(HLb + ro), h0b = *(const f4v*)(HLb + ro + 4);
        const f4v a0a = *(const f4v*)(HLb + (size_t)M * 256 + ro), a0b = *(const f4v*)(HLb + (size_t)M * 256 + ro + 4);
        const f4v h1a = *(const f4v*)(HLb1 + ro), h1b = *(const f4v*)(HLb1 + ro + 4);
        const f4v a1a = *(const f4v*)(HLb1 + (size_t)M * 256 + ro), a1b = *(const f4v*)(HLb1 + (size_t)M * 256 + ro + 4);
        const u4v xg = *(const u4v*)(Zb + (size_t)r * ZP + ZXG + ch0);
        float y[8];
#pragma unroll
        for (int i = 0; i < 4; ++i) {
            y[i] = (h0a[i] + a0a[i] * car0[i]) + (h1a[i] + a1a[i] * car1[i]);
            y[4 + i] = (h0b[i] + a0b[i] * car0[4 + i]) + (h1b[i] + a1b[i] * car1[4 + i]);
        }
        u4v o;
#pragma unroll
        for (int i = 0; i < 4; ++i) o[i] = pk2(y[2 * i] * gelu_t(lo16(xg[i])), y[2 * i + 1] * gelu_t(hi16(xg[i])));
        *(u4v*)(Yb + (size_t)r * D + 768 + ch0) = o;
    }
}

__device__ __forceinline__ void phase_mixers_fast(const Params& p, int l, unsigned char* smem, int* s_item, int ctr_off) {
    const int tid = threadIdx.x;
    float* biasLds = (float*)(smem + BIAS_OFF_B);
    for (int i = tid; i < 4 * 465; i += 256) biasLds[i] = p.na_bias[(size_t)l * 4 * 465 + i];
    unsigned* ctr = (unsigned*)(p.ws + WS_CTL) + l + ctr_off;
    const int nctx = (l == 0) ? 48 : 0;
    const int total = 512 + LRU_ITEMS + 2 * 512 + nctx;
    __syncthreads();
    while (true) {
        if (tid == 0) *s_item = (int)atomicAdd(ctr, 1u);
        __syncthreads();
        const int item = *s_item;
        __syncthreads();
        if (item >= total) break;
        if (item < 512) {
            const int b = item >> 7, rem = item & 127;
            attn_item_fast<1>(p, l, b, rem >> 6, rem & 63, false, (bf16*)smem, biasLds);
        } else if (item < 512 + LRU_ITEMS) {
            const int v = item - 512;
            const int seg = v % LRU_NSEG, w = v / LRU_NSEG;
            lru_item_fast(p, l, w >> 3, (w >> 1) & 3, w & 1, seg, smem);
        } else if (item < 512 + LRU_ITEMS + 1024) {
            const int v = item - 512 - LRU_ITEMS, idx = v & 511;
            const int b = idx >> 7, rem = idx & 127;
            if (v < 512) attn_item_fast<2>(p, l, b, rem >> 5, rem & 31, false, (bf16*)smem, biasLds);
            else attn_item_fast<0>(p, l, b, rem >> 6, rem & 63, false, (bf16*)smem, biasLds);
        } else {
            const int v = item - 512 - LRU_ITEMS - 1024, ko = v >> 4, rem = v & 15;
            const int kind = (ko == 0) ? 1 : (ko == 1 ? 0 : 2);
            const int b = rem >> 2, x = rem & 3;
            if (kind == 2) attn_item_fast<2>(p, l, b, x, 0, true, (bf16*)smem, biasLds);
            else if (kind == 1) attn_item_fast<1>(p, l, b, x >> 1, x & 1, true, (bf16*)smem, biasLds);
            else attn_item_fast<0>(p, l, b, x >> 1, x & 1, true, (bf16*)smem, biasLds);
        }
        __syncthreads();
    }
}

__device__ __forceinline__ void fp8x16_to_f32(const u4v w, float (&f)[16]) {
#pragma unroll
    for (int i = 0; i < 4; ++i) {
        const f2v lo = __builtin_amdgcn_cvt_pk_f32_fp8((int)w[i], false), hi = __builtin_amdgcn_cvt_pk_f32_fp8((int)w[i], true);
        f[i * 4] = lo[0]; f[i * 4 + 1] = lo[1]; f[i * 4 + 2] = hi[0]; f[i * 4 + 3] = hi[1];
    }
}
__device__ __forceinline__ float xch32(float v, int lane) {
    const unsigned b = __float_as_uint(v);
    const auto r = __builtin_amdgcn_permlane32_swap(b, b, false, false);
    return __uint_as_float((lane & 32) ? r[0] : r[1]);
}
__device__ __forceinline__ float xch16(float v, int lane) {
    const unsigned b = __float_as_uint(v);
    const auto r = __builtin_amdgcn_permlane16_swap(b, b, false, false);
    return __uint_as_float((lane & 16) ? r[0] : r[1]);
}
template <int CTRL>
__device__ __forceinline__ float dppf(float v) { return __uint_as_float((unsigned)__builtin_amdgcn_update_dpp(0, (int)__float_as_uint(v), CTRL, 0xF, 0xF, false)); }
__device__ __forceinline__ float xch8(float v) { return dppf<0x128>(v); }
__device__ __forceinline__ float xch4(float v) { return dppf<0x1B>(dppf<0x141>(v)); }
__device__ __forceinline__ float xch2(float v) { return dppf<0x4E>(v); }
__device__ __forceinline__ float xch1(float v) { return dppf<0xB1>(v); }

__device__ __forceinline__ void phase_peer(const Params& p, int l) {
    const int tidx = tid_op(), lane = tidx & 63, gw = blockIdx.x * 4 + __builtin_amdgcn_readfirstlane(tidx >> 6), nw = gridDim.x * 4;
    const bf16* H = (const bf16*)(p.ws + WS_H);
    const unsigned char* U = p.ws + WS_U + (size_t)l * NE * D;
    const unsigned char* V = p.ws + WS_V + (size_t)l * NE * D;
    const float* US = (const float*)(p.ws + WS_US) + (size_t)l * NE;
    const float* VS = (const float*)(p.ws + WS_VS) + (size_t)l * NE;
    const float* stop = (const float*)(p.ws + WS_STOP);
    const unsigned char* itop = p.ws + WS_ITOP;
    const float* modv = (const float*)(p.ws + WS_MOD);
    const int ci = (lane >= 16) + (lane >= 24) + (lane >= 29) + (lane >= 33) + (lane >= 36) + (lane >= 38) + (lane >= 40) + (lane >= 42)
                 + (lane >= 43) + (lane >= 44) + (lane >= 45) + (lane >= 46) + (lane >= 47) + (lane >= 48) + (lane >= 49);
    const int cpre = (ci == 0) ? 0 : (ci == 1) ? 16 : (ci == 2) ? 24 : (ci == 3) ? 29 : (ci == 4) ? 33 : (ci == 5) ? 36 : (ci == 6) ? 38 : (ci == 7) ? 40 : 34 + ci;
    const int cj = (lane - cpre) & 15;
    const bool cvalid = lane < 50;
    for (int r = gw; r < M; r += nw) {
        const int mi = mod_idx(r);
        if (l == 1 && mi == 4) continue;
        float hf[16];
        {
            const bf16* hrow = H + (size_t)r * D + lane * 16;
            const u4v h0 = *(const u4v*)hrow, h1 = *(const u4v*)(hrow + 8);
#pragma unroll
            for (int i = 0; i < 4; ++i) { hf[2 * i] = lo16(h0[i]); hf[2 * i + 1] = hi16(h0[i]); hf[8 + 2 * i] = lo16(h1[i]); hf[8 + 2 * i + 1] = hi16(h1[i]); }
        }
        float out[16];
#pragma unroll
        for (int i = 0; i < 16; ++i) out[i] = 0.f;
        float st_n = -3e38f; int it_n = 0;
        if (lane < 32) { st_n = stop[(size_t)r * 256 + lane]; it_n = itop[(size_t)r * 256 + lane]; }
#pragma unroll 1
        for (int hh = 0; hh < 8; ++hh) {
            const float st = st_n; const int it = it_n;
            if (hh + 1 < 8 && lane < 32) { st_n = stop[(size_t)r * 256 + (hh + 1) * 32 + lane]; it_n = itop[(size_t)r * 256 + (hh + 1) * 32 + lane]; }
            const float cand = cvalid ? __shfl(st, ci) + __shfl(st, 16 + cj) : -3e38f;
            const int ecand = __shfl(it, ci) * 128 + __shfl(it, 16 + cj);
            const unsigned key = (f2ord(cand) & ~63u) | (unsigned)(63 - lane);
            unsigned thr = 0u;
#pragma unroll
            for (int bit = 31; bit >= 0; --bit) {
                const unsigned t = thr | (1u << bit);
                if (__popcll(__ballot(key >= t)) >= 16) thr = t;
            }
            const bool sel = key >= thr;
            const unsigned long long selm = __ballot(sel);
            const unsigned long long m2 = sel ? selm : ~selm;
            const int rank = __builtin_amdgcn_mbcnt_hi((unsigned)(m2 >> 32), __builtin_amdgcn_mbcnt_lo((unsigned)m2, 0u));
            const int dst = sel ? rank : 16 + rank;
            const float smax = __uint_as_float(__builtin_amdgcn_readlane(__float_as_uint(cand), 0));
            const float mys = __uint_as_float(__builtin_amdgcn_ds_permute(dst * 4, __float_as_uint(cand)));
            const int e = __builtin_amdgcn_ds_permute(dst * 4, ecand);
            const float su = US[e], sv = VS[e];
            float ex = (lane < 16) ? __expf(mys - smax) : 0.f;
            float esum = ex;
            esum += xch8(esum); esum += xch4(esum); esum += xch2(esum); esum += xch1(esum);
            float gate = (lane < 16) ? ex / esum : 0.f;
            u4v ur[16], vr[16];
#pragma unroll
            for (int k = 0; k < 16; ++k) { const int ek = __builtin_amdgcn_readlane(e, k); ur[k] = *(const u4v*)(U + (size_t)ek * D + lane * 16); }
#pragma unroll
            for (int k = 0; k < 16; ++k) { const int ek = __builtin_amdgcn_readlane(e, k); vr[k] = *(const u4v*)(V + (size_t)ek * D + lane * 16); }
            float part[16];
#pragma unroll
            for (int k = 0; k < 16; ++k) {
                f2v a2 = {0.f, 0.f};
#pragma unroll
                for (int i = 0; i < 4; ++i) {
                    const f2v lo = __builtin_amdgcn_cvt_pk_f32_fp8((int)ur[k][i], false), hi = __builtin_amdgcn_cvt_pk_f32_fp8((int)ur[k][i], true);
                    a2 += lo * (f2v){hf[i * 4], hf[i * 4 + 1]};
                    a2 += hi * (f2v){hf[i * 4 + 2], hf[i * 4 + 3]};
                }
                part[k] = a2[0] + a2[1];
            }
            float q8[8], q4[4], q2[2], q1;
            { const bool hi = (lane & 32) != 0;
#pragma unroll
              for (int k = 0; k < 8; ++k) { float send = hi ? part[k] : part[k + 8], keep = hi ? part[k + 8] : part[k]; q8[k] = keep + xch32(send, lane); } }
            { const bool hi = (lane & 16) != 0;
#pragma unroll
              for (int k = 0; k < 4; ++k) { float send = hi ? q8[k] : q8[k + 4], keep = hi ? q8[k + 4] : q8[k]; q4[k] = keep + xch16(send, lane); } }
            { const bool hi = (lane & 8) != 0;
#pragma unroll
              for (int k = 0; k < 2; ++k) { float send = hi ? q4[k] : q4[k + 2], keep = hi ? q4[k + 2] : q4[k]; q2[k] = keep + xch8(send); } }
            { const bool hi = (lane & 4) != 0; float send = hi ? q2[0] : q2[1], keep = hi ? q2[1] : q2[0]; q1 = keep + xch4(send); }
            q1 += xch2(q1); q1 += xch1(q1);
            const int kk = (lane >> 2) & 15;
            const float coef = gelu_t(q1 * __shfl(su, kk)) * __shfl(gate, kk) * __shfl(sv, kk);
#pragma unroll
            for (int k = 0; k < 16; ++k) {
                const float ck = __uint_as_float(__builtin_amdgcn_readlane(__float_as_uint(coef), 4 * k));
                float vf[16];
                fp8x16_to_f32(vr[k], vf);
#pragma unroll
                for (int i = 0; i < 16; ++i) out[i] += ck * vf[i];
            }
        }
        float* xr = xs_row(p, r) + lane * 16;
        float xv[16];
#pragma unroll
        for (int i = 0; i < 4; ++i) { const float4 t = *(const float4*)(xr + i * 4); xv[i * 4] = t.x; xv[i * 4 + 1] = t.y; xv[i * 4 + 2] = t.z; xv[i * 4 + 3] = t.w; }
        const float* mv = modv + ((size_t)l * 5 + mi) * 6144;
#pragma unroll
        for (int i = 0; i < 16; ++i) xv[i] += mv[5120 + lane * 16 + i] * out[i];
        float ss = 0.f;
#pragma unroll
        for (int i = 0; i < 16; ++i) ss += xv[i] * xv[i];
        ss = wave_sum(ss);
        const float rstd = rsqrtf(ss * (1.f / 1024.f) + EPS);
        if (l == 0) {
#pragma unroll
            for (int i = 0; i < 4; ++i) *(float4*)(xr + i * 4) = make_float4(xv[i * 4], xv[i * 4 + 1], xv[i * 4 + 2], xv[i * 4 + 3]);
            const float* mv1 = modv + ((size_t)1 * 5 + mi) * 6144;
            const float* g = p.norm_mix + D;
            float o[16];
#pragma unroll
            for (int i = 0; i < 16; ++i) { const int e0 = lane * 16 + i; o[i] = xv[i] * rstd * g[e0] * (1.f + mv1[1024 + e0]) + mv1[e0]; }
            u4v w0, w1;
#pragma unroll
            for (int i = 0; i < 4; ++i) { w0[i] = pk2(o[2 * i], o[2 * i + 1]); w1[i] = pk2(o[8 + 2 * i], o[8 + 2 * i + 1]); }
            bf16* hrow = (bf16*)(p.ws + WS_H) + (size_t)r * D + lane * 16;
            *(u4v*)hrow = w0; *(u4v*)(hrow + 8) = w1;
        } else {
#pragma unroll
            for (int i = 0; i < 4; ++i) {
                const float4 g4 = *(const float4*)(p.norm_final + lane * 16 + i * 4);
                *(float4*)(xr + i * 4) = make_float4(xv[i * 4] * rstd * g4.x, xv[i * 4 + 1] * rstd * g4.y, xv[i * 4 + 2] * rstd * g4.z, xv[i * 4 + 3] * rstd * g4.w);
            }
        }
    }
}

__device__ __forceinline__ void grid_bar(unsigned* ctl, unsigned& gen) {
    __syncthreads();
    gen += 1;
    unsigned* arrive = ctl + 256;
    unsigned* release = ctl + 896;
    if (threadIdx.x == 0) {
        __threadfence();
        __hip_atomic_store(arrive + blockIdx.x, gen, __ATOMIC_RELAXED, __HIP_MEMORY_SCOPE_AGENT);
    }
    if (blockIdx.x == 0) {
        for (unsigned i = threadIdx.x; i < gridDim.x; i += 256)
            while (__hip_atomic_load(arrive + i, __ATOMIC_RELAXED, __HIP_MEMORY_SCOPE_AGENT) < gen) __builtin_amdgcn_s_sleep(1);
        __syncthreads();
        if (threadIdx.x == 0) __hip_atomic_store(release, gen, __ATOMIC_RELAXED, __HIP_MEMORY_SCOPE_AGENT);
    }
    if (threadIdx.x == 0) {
        while (__hip_atomic_load(release, __ATOMIC_RELAXED, __HIP_MEMORY_SCOPE_AGENT) < gen) __builtin_amdgcn_s_sleep(1);
        __threadfence();
    }
    __syncthreads();
}

#ifndef DUP_MASK
#define DUP_MASK 0
#endif
__global__ void __launch_bounds__(256, 2) fwd_megakernel(Params p) {
    __shared__ __attribute__((aligned(16))) unsigned char smem[SMEM_BYTES];
    float* lds = (float*)smem;
    __shared__ int s_item;
    cg::grid_group grid = cg::this_grid();
    unsigned* gbar = (unsigned*)(p.ws + WS_CTL);
    unsigned gtarget = 0;
    phase0(p, lds);
    grid.sync();
    if (DUP_MASK & 1) { phase0(p, lds); grid_bar(gbar, gtarget); }
    phase_rownorm(p, 0, 0);
    grid_bar(gbar, gtarget);
#pragma unroll 1
    for (int l = 0; l < 2; ++l) {
        phase_inproj_fast(p, l, (bf16*)smem);
        grid_bar(gbar, gtarget);
        if (DUP_MASK & 2) { phase_inproj_fast(p, l, (bf16*)smem); grid_bar(gbar, gtarget); }
        phase_mixers_fast(p, l, smem, &s_item, 0);
        grid_bar(gbar, gtarget);
        if (DUP_MASK & 4) { phase_mixers_fast(p, l, smem, &s_item, 2); grid_bar(gbar, gtarget); }
        phase_lru_combine(p, l);
        grid_bar(gbar, gtarget);
        phase_outproj_fast(p, l, (bf16*)smem);
        grid_bar(gbar, gtarget);
        if ((DUP_MASK & 32) && l == 0) { phase_outproj_fast(p, l, (bf16*)smem); grid_bar(gbar, gtarget); }
        phase_rownorm(p, l, 1);
        grid_bar(gbar, gtarget);
        if (DUP_MASK & 16) { phase_rownorm(p, l, 1); grid_bar(gbar, gtarget); }
        phase_peerq_fast(p, l, (bf16*)smem);
        grid_bar(gbar, gtarget);
        if (DUP_MASK & 8) { phase_peerq_fast(p, l, (bf16*)smem); grid_bar(gbar, gtarget); }
        phase_peer(p, l);
        if (l == 0) grid_bar(gbar, gtarget);
    }
}

extern "C" void kernel_launch(void* const* d_in, const int* in_sizes, int n_in, void* d_out, int out_size, void* d_ws, size_t ws_size, hipStream_t stream) {
    static int grid_blocks = 0;
    if (!grid_blocks) {
        int dev = 0, cus = 0, per_cu = 0;
        hipGetDevice(&dev);
        hipDeviceGetAttribute(&cus, hipDeviceAttributeMultiprocessorCount, dev);
        hipOccupancyMaxActiveBlocksPerMultiprocessor(&per_cu, fwd_megakernel, 256, 0);
        if (per_cu > 2) per_cu = 2;
        if (per_cu < 1) per_cu = 1;
        grid_blocks = cus * per_cu;
        if (grid_blocks > 512) grid_blocks = 512;
        if (ws_size < WS_END) fprintf(stderr, "kernel_launch: workspace too small: need %zu have %zu\n", (size_t)WS_END, ws_size);
    }
    Params p{};
    const float** pp = (const float**)&p;
    for (int i = 0; i < 26; ++i) pp[i] = (const float*)d_in[i];
    p.out = (float*)d_out;
    p.ws = (unsigned char*)d_ws;
    (void)hipMemsetAsync((char*)d_ws + WS_CTL, 0, 4096, stream);
    void* args[] = {&p};
    hipError_t e = hipLaunchCooperativeKernel((void*)fwd_megakernel, dim3(grid_blocks), dim3(256), args, 0, stream);
    if (e != hipSuccess) fprintf(stderr, "cooperative launch failed: %s (grid %d)\n", hipGetErrorString(e), grid_blocks);
}
```

```cpp
#include <hip/hip_runtime.h>
#include <hip/hip_cooperative_groups.h>
#include <cstdio>
#include <cstdint>
namespace cg = cooperative_groups;

typedef unsigned short bf16;
typedef __bf16 bf2_t __attribute__((ext_vector_type(2)));
typedef unsigned u4v __attribute__((ext_vector_type(4)));

constexpr int D = 1024, NB = 4, SEQ = 8192, LC = 256, TB = SEQ + LC  , M = NB * TB  ;
constexpr int DIN = 2304, ZP = 1792;
constexpr int NE = 16384;
constexpr int ZQA = 0, ZKA = 256, ZQB = 384, ZKB = 640, ZQN = 768, ZKN = 1024, ZXR = 1280, ZXG = 1536;
constexpr float EPS = 1e-6f;

constexpr size_t al(size_t x) { return (x + 255) & ~(size_t)255; }
constexpr size_t WS_CTL = 0;
constexpr size_t WS_WIN = 4096;
constexpr size_t WS_WOUT = WS_WIN + al((size_t)2 * DIN * D * 2);
constexpr size_t WS_WQ = WS_WOUT + al((size_t)2 * D * D * 2);
constexpr size_t WS_KEYS = WS_WQ + al((size_t)2 * 2048 * D * 2);
constexpr size_t WS_LRUW = WS_KEYS + al((size_t)2 * 2 * 128 * 128 * 2);
constexpr size_t WS_U = WS_LRUW + al((size_t)2 * 2 * 2 * 4 * 4096 * 2);
constexpr size_t WS_V = WS_U + al((size_t)2 * NE * D);
constexpr size_t WS_US = WS_V + al((size_t)2 * NE * D);
constexpr size_t WS_VS = WS_US + al((size_t)2 * NE * 4);
constexpr size_t WS_MOD = WS_VS + al((size_t)2 * NE * 4);
constexpr size_t WS_ROPE = WS_MOD + al((size_t)2 * 5 * 6144 * 4);
constexpr size_t WS_H = WS_ROPE + al((size_t)128 * 16 * 8);
constexpr size_t WS_Z = WS_H + al((size_t)M * D * 2);
constexpr size_t WS_VTA = WS_Z + al((size_t)M * ZP * 2);
constexpr size_t WS_VTB = WS_VTA + al((size_t)NB * 2 * 64 * TB * 2);
constexpr size_t WS_VTN = WS_VTB + al((size_t)NB * 2 * 64 * TB * 2);
constexpr size_t WS_Y = WS_VTN + al((size_t)NB * 4 * 64 * TB * 2);
constexpr size_t WS_HF = WS_Y + al((size_t)M * D * 2);
constexpr size_t WS_AGG = WS_HF + al((size_t)2 * M * 256 * 4);
constexpr size_t WS_XC = WS_AGG + al((size_t)16 * 2 * 12 * 2 * 64 * 4);
constexpr size_t WS_END = WS_XC + al((size_t)NB * LC * D * 4);
constexpr size_t WS_STOP = WS_Z;
constexpr size_t WS_ITOP = WS_Z + al((size_t)M * 256 * 4);

struct Params {
    const float *x, *c, *ctx, *c_ctx, *w_mod, *b_mod, *norm_mix, *norm_ffn, *w_in, *w_out, *attn_sink, *qn_g, *kn_g, *na_bias,
        *conv_w, *conv_b, *lru_wa, *lru_ba, *lru_wx, *lru_bx, *lru_lam, *peer_wq, *peer_keys, *peer_u, *peer_v, *norm_final;
    float* out;
    unsigned char* ws;
};

__device__ __forceinline__ float bf2f(bf16 v) { return __uint_as_float((unsigned)v << 16); }
__device__ __forceinline__ bf16 f2bf(float f) { unsigned u = __float_as_uint(f); return (bf16)((u + 0x7fffu + ((u >> 16) & 1u)) >> 16); }
typedef __bf16 bf16x2_t __attribute__((ext_vector_type(2)));
typedef float f32x2_t __attribute__((ext_vector_type(2)));
__device__ __forceinline__ unsigned pk2(float lo, float hi) { f32x2_t v = {lo, hi}; return __builtin_bit_cast(unsigned, __builtin_convertvector(v, bf16x2_t)); }
__device__ __forceinline__ float lo16(unsigned w) { return __uint_as_float(w << 16); }
__device__ __forceinline__ float hi16(unsigned w) { return __uint_as_float(w & 0xffff0000u); }
__device__ __forceinline__ float dot2(unsigned a, unsigned b, float c) { return __builtin_amdgcn_fdot2_f32_bf16(__builtin_bit_cast(bf2_t, a), __builtin_bit_cast(bf2_t, b), c, false); }
__device__ __forceinline__ float dot8(uint4 a, uint4 b, float c) { c = dot2(a.x, b.x, c); c = dot2(a.y, b.y, c); c = dot2(a.z, b.z, c); return dot2(a.w, b.w, c); }
__device__ __forceinline__ float wave_sum(float v) {
#pragma unroll
    for (int o = 32; o > 0; o >>= 1) v += __shfl_xor(v, o);
    return v;
}
__device__ __forceinline__ float wave_max(float v) {
#pragma unroll
    for (int o = 32; o > 0; o >>= 1) v = fmaxf(v, __shfl_xor(v, o));
    return v;
}
__device__ __forceinline__ float gelu_t(float x) { float u = 0.7978845608028654f * (x + 0.044715f * x * x * x); return x * __builtin_amdgcn_rcpf(1.f + __expf(-2.f * u)); }
__device__ __forceinline__ float sigmoidf_(float x) { return 1.f / (1.f + __expf(-x)); }

__device__ __forceinline__ int tid_op() { int t = threadIdx.x; asm volatile("" : "+v"(t)); return t; }

__device__ __forceinline__ void lds_barrier() { asm volatile("s_waitcnt lgkmcnt(0)\n\ts_barrier" ::: "memory"); }

__device__ __forceinline__ const float* in_row(const Params& p, int r) {
    int b = r / TB, j = r - b * TB;
    return (j < LC) ? p.ctx + ((size_t)b * LC + j) * D : p.x + ((size_t)b * SEQ + (j - LC)) * D;
}
__device__ __forceinline__ float* xs_row(const Params& p, int r) {
    int b = r / TB, j = r - b * TB;
    return (j < LC) ? (float*)(p.ws + WS_XC) + ((size_t)b * LC + j) * D : p.out + ((size_t)b * SEQ + (j - LC)) * D;
}
__device__ __forceinline__ int mod_idx(int r) { int b = r / TB, j = r - b * TB; return (j < LC) ? 4 : b; }

__device__ __forceinline__ void p0_mod(const Params& p, float* lds) {
    float* sv = lds;
    float* red = lds + 5 * 1024;
    const int tid = threadIdx.x, lane = tid & 63, wave = tid >> 6;
    for (int i = tid; i < 5 * 1024; i += 256) {
        int bi = i >> 10, k = i & 1023;
        float v = (bi < 4) ? p.c[bi * 1024 + k] : p.c_ctx[k];
        sv[i] = v / (1.f + __expf(-v));
    }
    __syncthreads();
    float* modv = (float*)(p.ws + WS_MOD);
    for (int it = blockIdx.x; it < 2 * 96; it += gridDim.x) {
        int l = it / 96, col = (it % 96) * 64 + lane;
        const float* w = p.w_mod + (size_t)l * D * 6144 + col;
        float a0 = 0, a1 = 0, a2 = 0, a3 = 0, a4 = 0;
        int k0 = wave * 256;
#pragma unroll 8
        for (int k = k0; k < k0 + 256; ++k) {
            float wv = w[(size_t)k * 6144];
            a0 += sv[k] * wv; a1 += sv[1024 + k] * wv; a2 += sv[2048 + k] * wv; a3 += sv[3072 + k] * wv; a4 += sv[4096 + k] * wv;
        }
        red[(wave * 5 + 0) * 64 + lane] = a0; red[(wave * 5 + 1) * 64 + lane] = a1; red[(wave * 5 + 2) * 64 + lane] = a2;
        red[(wave * 5 + 3) * 64 + lane] = a3; red[(wave * 5 + 4) * 64 + lane] = a4;
        __syncthreads();
        for (int i = tid; i < 320; i += 256) {
            int bi = i / 64, cl = i % 64;
            float s = red[(0 * 5 + bi) * 64 + cl] + red[(1 * 5 + bi) * 64 + cl] + red[(2 * 5 + bi) * 64 + cl] + red[(3 * 5 + bi) * 64 + cl];
            int cc = (it % 96) * 64 + cl;
            modv[((size_t)l * 5 + bi) * 6144 + cc] = s + p.b_mod[l * 6144 + cc];
        }
        __syncthreads();
    }
}
__device__ __forceinline__ void p0_transpose(const float* src, bf16* dst, int K, int N, int nmat, float* lds) {
    const int tid = threadIdx.x;
    const int tk = K / 64, tn = N / 64, per = tk * tn;
    for (int it = blockIdx.x; it < nmat * per; it += gridDim.x) {
        int mat = it / per, t = it % per, k0 = (t / tn) * 64, n0 = (t % tn) * 64;
        const float* s = src + (size_t)mat * K * N;
        bf16* d = dst + (size_t)mat * K * N;
        for (int i = tid; i < 4096; i += 256) { int kk = i >> 6, nn = i & 63; lds[kk * 65 + nn] = s[(size_t)(k0 + kk) * N + n0 + nn]; }
        __syncthreads();
        for (int i = tid; i < 4096; i += 256) { int nn = i >> 6, kk = i & 63; d[(size_t)(n0 + nn) * K + k0 + kk] = f2bf(lds[kk * 65 + nn]); }
        __syncthreads();
    }
}
__device__ __forceinline__ void p0_convert(const float* src, bf16* dst, size_t n) {
    size_t i = ((size_t)blockIdx.x * 256 + threadIdx.x) * 4, st = (size_t)gridDim.x * 256 * 4;
    for (; i < n; i += st) {
        float4 v = *(const float4*)(src + i);
        uint2 o; o.x = pk2(v.x, v.y); o.y = pk2(v.z, v.w);
        *(uint2*)(dst + i) = o;
    }
}

typedef float f2v __attribute__((ext_vector_type(2)));
__device__ __forceinline__ void p0_convert_fp8(const float* src, unsigned char* dst, float* scales, int nrows) {
    const int tidx = tid_op(), lane = tidx & 63, gw = blockIdx.x * 4 + __builtin_amdgcn_readfirstlane(tidx >> 6), nw = gridDim.x * 4;
    for (int r = gw; r < nrows; r += nw) {
        const float* row = src + (size_t)r * D + lane * 16;
        float v[16];
#pragma unroll
        for (int i = 0; i < 4; ++i) { float4 t = *(const float4*)(row + i * 4); v[i * 4] = t.x; v[i * 4 + 1] = t.y; v[i * 4 + 2] = t.z; v[i * 4 + 3] = t.w; }
        float am = 0.f;
#pragma unroll
        for (int i = 0; i < 16; ++i) am = fmaxf(am, fabsf(v[i]));
        am = wave_max(am);
        const float inv = (am > 0.f) ? 448.f / am : 1.f;
        u4v w;
#pragma unroll
        for (int i = 0; i < 4; ++i) {
            int t = 0;
            t = __builtin_amdgcn_cvt_pk_fp8_f32(v[i * 4] * inv, v[i * 4 + 1] * inv, t, false);
            t = __builtin_amdgcn_cvt_pk_fp8_f32(v[i * 4 + 2] * inv, v[i * 4 + 3] * inv, t, true);
            w[i] = (unsigned)t;
        }
        *(u4v*)(dst + (size_t)r * D + lane * 16) = w;
        if (lane == 0) scales[r] = (am > 0.f) ? am * (1.f / 448.f) : 1.f;
    }
}
__device__ __forceinline__ void phase0(const Params& p, float* lds) {
    p0_mod(p, lds);
    __syncthreads();
    p0_transpose(p.w_in, (bf16*)(p.ws + WS_WIN), D, DIN, 2, lds);
    p0_transpose(p.w_out, (bf16*)(p.ws + WS_WOUT), D, D, 2, lds);
    p0_transpose(p.peer_wq, (bf16*)(p.ws + WS_WQ), D, 2048, 2, lds);
    for (int g = 0; g < 2; ++g) {
        const float* src = g ? p.lru_wx : p.lru_wa;
        for (int ld = 0; ld < 4; ++ld)
            p0_transpose(src + (size_t)ld * 4 * 4096, (bf16*)(p.ws + WS_LRUW) + ((size_t)(ld * 2 + g) * 4) * 4096, 64, 64, 4, lds);
    }
    p0_convert(p.peer_keys, (bf16*)(p.ws + WS_KEYS), (size_t)2 * 2 * 128 * 128);
    p0_convert_fp8(p.peer_u, p.ws + WS_U, (float*)(p.ws + WS_US), 2 * NE);
    p0_convert_fp8(p.peer_v, p.ws + WS_V, (float*)(p.ws + WS_VS), 2 * NE);
    if (blockIdx.x == gridDim.x - 1) {
        float2* rt = (float2*)(p.ws + WS_ROPE);
        for (int i = threadIdx.x; i < 128 * 16; i += 256) {
            int pos = i >> 4, f = i & 15;
            float inv = powf(10000.f, -(float)f / 16.f);
            float ang = (float)pos * inv;
            rt[i] = make_float2(cosf(ang), sinf(ang));
        }
    }
}

__device__ __forceinline__ void modnorm_store(const float (&v)[16], const float* g, const float* sc, const float* sh, bf16* hrow, int lane) {
    float ss = 0;
#pragma unroll
    for (int i = 0; i < 16; ++i) ss += v[i] * v[i];
    ss = wave_sum(ss);
    float rstd = rsqrtf(ss * (1.f / 1024.f) + EPS);
#pragma unroll
    for (int hh = 0; hh < 2; ++hh) {
        int e0 = hh * 512 + lane * 8;
        float o[8];
#pragma unroll
        for (int i = 0; i < 8; ++i) o[i] = v[hh * 8 + i] * rstd * g[e0 + i] * (1.f + sc[e0 + i]) + sh[e0 + i];
        uint4 w; w.x = pk2(o[0], o[1]); w.y = pk2(o[2], o[3]); w.z = pk2(o[4], o[5]); w.w = pk2(o[6], o[7]);
        *(uint4*)(hrow + e0) = w;
    }
}
__device__ __forceinline__ void load_row16(const float* row, float (&v)[16], int lane) {
    float4 a = *(const float4*)(row + lane * 8), b = *(const float4*)(row + lane * 8 + 4);
    float4 c = *(const float4*)(row + 512 + lane * 8), d = *(const float4*)(row + 512 + lane * 8 + 4);
    v[0] = a.x; v[1] = a.y; v[2] = a.z; v[3] = a.w; v[4] = b.x; v[5] = b.y; v[6] = b.z; v[7] = b.w;
    v[8] = c.x; v[9] = c.y; v[10] = c.z; v[11] = c.w; v[12] = d.x; v[13] = d.y; v[14] = d.z; v[15] = d.w;
}
__device__ __forceinline__ void phase_rownorm(const Params& p, int l, int which) {
    const int tidx = tid_op(), lane = tidx & 63, gw = blockIdx.x * 4 + __builtin_amdgcn_readfirstlane(tidx >> 6), nw = gridDim.x * 4;
    const float* modv = (const float*)(p.ws + WS_MOD);
    bf16* H = (bf16*)(p.ws + WS_H);
    const int rpw = (M + nw - 1) / nw;
    const float* g = (which ? p.norm_ffn : p.norm_mix) + l * D;
    int cur_mi = -1;
    float gs[16], shv[16];
    for (int r = gw * rpw; r < (gw + 1) * rpw && r < M; ++r) {
        const int mi = mod_idx(r);
        if (l == 1 && which == 1 && mi == 4) continue;
        if (mi != cur_mi) {
            cur_mi = mi;
            const float* mv = modv + ((size_t)l * 5 + mi) * 6144;
            const float* sc = mv + (which ? 4096 : 1024); const float* sh = mv + (which ? 3072 : 0);
#pragma unroll
            for (int hh = 0; hh < 2; ++hh)
#pragma unroll
                for (int i = 0; i < 8; ++i) { const int e0 = hh * 512 + lane * 8 + i; gs[hh * 8 + i] = g[e0] * (1.f + sc[e0]); shv[hh * 8 + i] = sh[e0]; }
        }
        float v[16];
        load_row16(which ? xs_row(p, r) : in_row(p, r), v, lane);
        float ss = 0.f;
#pragma unroll
        for (int i = 0; i < 16; ++i) ss += v[i] * v[i];
        ss = wave_sum(ss);
        const float rstd = rsqrtf(ss * (1.f / 1024.f) + EPS);
        bf16* hrow = H + (size_t)r * D;
#pragma unroll
        for (int hh = 0; hh < 2; ++hh) {
            u4v w;
#pragma unroll
            for (int i = 0; i < 4; ++i) w[i] = pk2(v[hh * 8 + 2 * i] * rstd * gs[hh * 8 + 2 * i] + shv[hh * 8 + 2 * i], v[hh * 8 + 2 * i + 1] * rstd * gs[hh * 8 + 2 * i + 1] + shv[hh * 8 + 2 * i + 1]);
            *(u4v*)(hrow + hh * 512 + lane * 8) = w;
        }
    }
}

typedef short s8v __attribute__((ext_vector_type(8)));
typedef float f4v __attribute__((ext_vector_type(4)));
#define MFMA16(a, b, c) __builtin_amdgcn_mfma_f32_16x16x32_bf16((a), (b), (c), 0, 0, 0)
constexpr int GP = 72;
constexpr int TLDS = 128 * GP;
constexpr int SMEM_BYTES = 4 * TLDS * 2;

template <bool SWAP>
__device__ __forceinline__ void gemm_mainloop(const bf16* __restrict__ A, const bf16* __restrict__ Bt, bf16* lds, f4v (&acc)[4][4]) {
    const int tid = tid_op(), lane = tid & 63, wave = tid >> 6, wm = wave >> 1, wn = wave & 1;
    const int lrow = tid >> 3, lkc = tid & 7;
    const bf16* ag = A + (size_t)lrow * D + lkc * 8;
    const bf16* bg = Bt + (size_t)lrow * D + lkc * 8;
    bf16* sa = lds + lrow * GP + lkc * 8;
    u4v ra[4], rb[4];
#pragma unroll
    for (int i = 0; i < 4; ++i) { ra[i] = *(const u4v*)(ag + (size_t)i * 32 * D); rb[i] = *(const u4v*)(bg + (size_t)i * 32 * D); }
#pragma unroll
    for (int i = 0; i < 4; ++i) { *(u4v*)(sa + i * 32 * GP) = ra[i]; *(u4v*)(sa + TLDS + i * 32 * GP) = rb[i]; }
    __syncthreads();
    const int fro = (lane & 15) * GP + (lane >> 4) * 8;
#pragma unroll 1
    for (int kt = 0; kt < 16; ++kt) {
        const int buf = kt & 1;
        if (kt + 1 < 16) {
#pragma unroll
            for (int i = 0; i < 4; ++i) { ra[i] = *(const u4v*)(ag + (size_t)i * 32 * D + (kt + 1) * 64); rb[i] = *(const u4v*)(bg + (size_t)i * 32 * D + (kt + 1) * 64); }
        }
        const bf16* As = lds + buf * 2 * TLDS + wm * 64 * GP + fro;
        const bf16* Bs = lds + buf * 2 * TLDS + TLDS + wn * 64 * GP + fro;
#pragma unroll
        for (int ks = 0; ks < 2; ++ks) {
            s8v af[4], bfr[4];
#pragma unroll
            for (int i = 0; i < 4; ++i) { af[i] = *(const s8v*)(As + i * 16 * GP + ks * 32); bfr[i] = *(const s8v*)(Bs + i * 16 * GP + ks * 32); }
            __builtin_amdgcn_s_setprio(1);
#pragma unroll
            for (int mi = 0; mi < 4; ++mi)
#pragma unroll
                for (int nj = 0; nj < 4; ++nj)
                    acc[mi][nj] = SWAP ? MFMA16(bfr[nj], af[mi], acc[mi][nj]) : MFMA16(af[mi], bfr[nj], acc[mi][nj]);
            __builtin_amdgcn_s_setprio(0);
        }
        if (kt + 1 < 16) {
            bf16* sd = sa + (buf ^ 1) * 2 * TLDS;
#pragma unroll
            for (int i = 0; i < 4; ++i) { *(u4v*)(sd + i * 32 * GP) = ra[i]; *(u4v*)(sd + TLDS + i * 32 * GP) = rb[i]; }
        }
        __syncthreads();
    }
}

__device__ __forceinline__ void phase_inproj_fast(const Params& p, int l, bf16* lds) {
    const int tid = tid_op(), lane = tid & 63, wave = tid >> 6, wm = wave >> 1, wn = wave & 1, l15 = lane & 15, gq = lane >> 4;
    const bf16* H = (const bf16*)(p.ws + WS_H);
    const bf16* W = (const bf16*)(p.ws + WS_WIN) + (size_t)l * DIN * D;
    bf16* Z = (bf16*)(p.ws + WS_Z);
    const float2* rt = (const float2*)(p.ws + WS_ROPE);
    for (int tile = blockIdx.x; tile < 264 * 18; tile += gridDim.x) {
        const int mt = tile / 18, nt = tile - mt * 18;
        const bf16* A = H + (size_t)mt * 128 * D;
        const bf16* Bt = W + (size_t)nt * 128 * D;
        const int bb = mt / 66, jt = (mt - bb * 66) * 128;
        f4v acc[4][4];
#pragma unroll
        for (int i = 0; i < 4; ++i)
#pragma unroll
            for (int j = 0; j < 4; ++j) acc[i][j] = (f4v){0.f, 0.f, 0.f, 0.f};
        const int s = nt * 2 + wn;
        const bool isv = (nt == 3) || (nt == 7) || (nt == 12) || (nt == 13);
        if (isv) {
            gemm_mainloop<false>(A, Bt, lds, acc);
            int vkind, vh;
            if (s < 8) { vkind = 0; vh = s - 6; } else if (s < 16) { vkind = 1; vh = s - 14; } else { vkind = 2; vh = s - 24; }
            bf16* vt = (vkind == 0) ? (bf16*)(p.ws + WS_VTA) + ((size_t)(bb * 2 + vh) * 64) * TB
                     : (vkind == 1) ? (bf16*)(p.ws + WS_VTB) + ((size_t)(bb * 2 + vh) * 64) * TB
                                    : (bf16*)(p.ws + WS_VTN) + ((size_t)(bb * 4 + vh) * 64) * TB;
            bf16* stg = lds + wave * (64 * GP);
#pragma unroll
            for (int mi = 0; mi < 4; ++mi)
#pragma unroll
                for (int nj = 0; nj < 4; ++nj) {
                    uint2 w; w.x = pk2(acc[mi][nj][0], acc[mi][nj][1]); w.y = pk2(acc[mi][nj][2], acc[mi][nj][3]);
                    *(uint2*)(stg + (nj * 16 + l15) * GP + mi * 16 + gq * 4) = w;
                }
#pragma unroll
            for (int it = 0; it < 8; ++it) {
                const int rs = it * 8 + (lane >> 3), ch = lane & 7;
                *(u4v*)(vt + (size_t)rs * TB + jt + wm * 64 + ch * 8) = *(const u4v*)(stg + rs * GP + ch * 8);
            }
        } else {
            gemm_mainloop<true>(A, Bt, lds, acc);
            int zcol; bool nrm = false, rope = false, isq = false; const float* g = p.qn_g;
            if (s < 4) { zcol = ZQA + 64 * s; rope = true; isq = true; }
            else if (s < 6) { zcol = ZKA + 64 * (s - 4); rope = true; }
            else if (s < 12) { zcol = ZQB + 64 * (s - 8); rope = true; isq = true; nrm = true; g = p.qn_g + l * 64; }
            else if (s < 14) { zcol = ZKB + 64 * (s - 12); rope = true; nrm = true; g = p.kn_g + l * 64; }
            else if (s < 20) { zcol = ZQN + 64 * (s - 16); isq = true; }
            else if (s < 24) { zcol = ZKN + 64 * (s - 20); }
            else if (s < 32) { zcol = ZXR + 64 * (s - 28); }
            else { zcol = ZXG + 64 * (s - 32); }
            const bool latent = jt >= LC;
            bf16* stg = lds + wave * (64 * GP);
#pragma unroll
            for (int mi = 0; mi < 4; ++mi) {
                const int j = jt + wm * 64 + mi * 16 + l15;
                float v[4][4];
#pragma unroll
                for (int nj = 0; nj < 4; ++nj)
#pragma unroll
                    for (int q = 0; q < 4; ++q) v[nj][q] = acc[mi][nj][q];
                if (nrm) {
                    float ss = 0.f;
#pragma unroll
                    for (int nj = 0; nj < 4; ++nj)
#pragma unroll
                        for (int q = 0; q < 4; ++q) ss += v[nj][q] * v[nj][q];
                    ss += __shfl_xor(ss, 16); ss += __shfl_xor(ss, 32);
                    const float rstd = rsqrtf(ss * (1.f / 64.f) + EPS);
#pragma unroll
                    for (int nj = 0; nj < 4; ++nj) {
                        const float4 g4 = *(const float4*)(g + nj * 16 + gq * 4);
                        v[nj][0] *= rstd * g4.x; v[nj][1] *= rstd * g4.y; v[nj][2] *= rstd * g4.z; v[nj][3] *= rstd * g4.w;
                    }
                }
                if (rope && latent) {
                    const int t = j - LC, pr = t >> 6, pc = t & 63;
                    const float4* r1 = (const float4*)(rt + pr * 16 + gq * 4);
                    const float4* r2 = (const float4*)(rt + pc * 16 + gq * 4);
                    const float4 a0 = r1[0], a1 = r1[1], b0 = r2[0], b1 = r2[1];
                    const float cs1[4][2] = {{a0.x, a0.y}, {a0.z, a0.w}, {a1.x, a1.y}, {a1.z, a1.w}};
                    const float cs2[4][2] = {{b0.x, b0.y}, {b0.z, b0.w}, {b1.x, b1.y}, {b1.z, b1.w}};
#pragma unroll
                    for (int q = 0; q < 4; ++q) {
                        const float x1 = v[0][q], x2 = v[1][q], y1 = v[2][q], y2 = v[3][q];
                        v[0][q] = x1 * cs1[q][0] - x2 * cs1[q][1]; v[1][q] = x1 * cs1[q][1] + x2 * cs1[q][0];
                        v[2][q] = y1 * cs2[q][0] - y2 * cs2[q][1]; v[3][q] = y1 * cs2[q][1] + y2 * cs2[q][0];
                    }
                }
                const float sc = isq ? (nrm ? 0.125f * 1.4426950408889634f : 0.125f) : 1.f;
#pragma unroll
                for (int nj = 0; nj < 4; ++nj) {
                    uint2 w; w.x = pk2(v[nj][0] * sc, v[nj][1] * sc); w.y = pk2(v[nj][2] * sc, v[nj][3] * sc);
                    *(uint2*)(stg + (mi * 16 + l15) * GP + nj * 16 + gq * 4) = w;
                }
            }
            {
                const size_t r0 = (size_t)bb * TB + jt + wm * 64;
#pragma unroll
                for (int it = 0; it < 8; ++it) {
                    const int rs = it * 8 + (lane >> 3), ch = lane & 7;
                    *(u4v*)(Z + (r0 + rs) * ZP + zcol + ch * 8) = *(const u4v*)(stg + rs * GP + ch * 8);
                }
            }
        }
        __syncthreads();
    }
}

__device__ __forceinline__ void phase_outproj_fast(const Params& p, int l, bf16* lds) {
    const int tid = tid_op(), lane = tid & 63, wave = tid >> 6, wm = wave >> 1, wn = wave & 1, l15 = lane & 15, gq = lane >> 4;
    const bf16* Y = (const bf16*)(p.ws + WS_Y);
    const bf16* W = (const bf16*)(p.ws + WS_WOUT) + (size_t)l * D * D;
    const float* modv = (const float*)(p.ws + WS_MOD);
    for (int tile = blockIdx.x; tile < 264 * 8; tile += gridDim.x) {
        const int mt = tile >> 3, nt = tile & 7;
        const int bb = mt / 66, jt = (mt - bb * 66) * 128;
        if (l == 1 && jt < LC) continue;
        f4v acc[4][4];
#pragma unroll
        for (int i = 0; i < 4; ++i)
#pragma unroll
            for (int j = 0; j < 4; ++j) acc[i][j] = (f4v){0.f, 0.f, 0.f, 0.f};
        gemm_mainloop<true>(Y + (size_t)mt * 128 * D, W + (size_t)nt * 128 * D, lds, acc);
        const float* gtv = modv + ((size_t)l * 5 + (jt < LC ? 4 : bb)) * 6144 + 2048;
#pragma unroll
        for (int mi = 0; mi < 4; ++mi) {
            const int r = bb * TB + jt + wm * 64 + mi * 16 + l15;
            const float* xin = (l == 0) ? in_row(p, r) : xs_row(p, r);
            float* xo = xs_row(p, r);
#pragma unroll
            for (int nj = 0; nj < 4; ++nj) {
                const int col = nt * 128 + wn * 64 + nj * 16 + gq * 4;
                const float4 xi = *(const float4*)(xin + col), gt = *(const float4*)(gtv + col);
                *(float4*)(xo + col) = make_float4(xi.x + gt.x * acc[mi][nj][0], xi.y + gt.y * acc[mi][nj][1], xi.z + gt.z * acc[mi][nj][2], xi.w + gt.w * acc[mi][nj][3]);
            }
        }
    }
}


__device__ __forceinline__ void ce_desc(unsigned& a, unsigned& b) { const unsigned hi = max(a, b), lo = min(a, b); a = hi; b = lo; }
__device__ __forceinline__ void bitonic_merge16(unsigned (&v)[16]) {
#pragma unroll
    for (int j = 8; j > 0; j >>= 1)
#pragma unroll
        for (int i = 0; i < 16; ++i) { const int l = i ^ j; if (l > i) ce_desc(v[i], v[l]); }
}
__device__ __forceinline__ void bitonic_sort16(unsigned (&v)[16]) {
#pragma unroll
    for (int k = 2; k <= 16; k <<= 1)
#pragma unroll
        for (int j = k >> 1; j > 0; j >>= 1)
#pragma unroll
            for (int i = 0; i < 16; ++i) {
                const int l = i ^ j;
                if (l > i) { if ((i & k) == 0 || k == 16) ce_desc(v[i], v[l]); else ce_desc(v[l], v[i]); }
            }
}
__device__ __forceinline__ unsigned f2ord(float f) { unsigned u = __float_as_uint(f); return (u & 0x80000000u) ? ~u : (u | 0x80000000u); }
__device__ __forceinline__ void phase_peerq_fast(const Params& p, int l, bf16* lds) {
    const int tid = tid_op(), lane = tid & 63, wave = tid >> 6, wm = wave >> 1, wn = wave & 1, l15 = lane & 15, gq = lane >> 4;
    const bf16* H = (const bf16*)(p.ws + WS_H);
    const bf16* W = (const bf16*)(p.ws + WS_WQ) + (size_t)l * 2048 * D;
    const bf16* KY = (const bf16*)(p.ws + WS_KEYS) + (size_t)l * 2 * 128 * 128;
    float* stop = (float*)(p.ws + WS_STOP);
    unsigned char* itop = p.ws + WS_ITOP;
    constexpr int QP = 136, SP = 132;
    bf16* Qs = lds; bf16* Ks = lds + 128 * QP;
    float* Sf = (float*)lds;
    for (int tile = blockIdx.x; tile < 264 * 16; tile += gridDim.x) {
        const int mt = tile >> 4, hp = tile & 15;
        const int bb = mt / 66, jt = (mt - bb * 66) * 128;
        if (l == 1 && jt < LC) continue;
        f4v acc[4][4];
#pragma unroll
        for (int i = 0; i < 4; ++i)
#pragma unroll
            for (int j = 0; j < 4; ++j) acc[i][j] = (f4v){0.f, 0.f, 0.f, 0.f};
        u4v kreg[8];
        {
            const bf16* kg = KY + (size_t)(hp & 1) * 128 * 128;
#pragma unroll
            for (int i = 0; i < 8; ++i) { int c = tid + i * 256, row = c >> 4, kc = c & 15; kreg[i] = *(const u4v*)(kg + row * 128 + kc * 8); }
        }
        gemm_mainloop<true>(H + (size_t)mt * 128 * D, W + (size_t)hp * 128 * D, lds, acc);
#pragma unroll
        for (int mi = 0; mi < 4; ++mi)
#pragma unroll
            for (int nj = 0; nj < 4; ++nj) {
                uint2 w; w.x = pk2(acc[mi][nj][0], acc[mi][nj][1]); w.y = pk2(acc[mi][nj][2], acc[mi][nj][3]);
                *(uint2*)(Qs + (wm * 64 + mi * 16 + l15) * QP + wn * 64 + nj * 16 + gq * 4) = w;
            }
#pragma unroll
        for (int i = 0; i < 8; ++i) { int c = tid + i * 256, row = c >> 4, kc = c & 15; *(u4v*)(Ks + row * QP + kc * 8) = kreg[i]; }
        __syncthreads();
        f4v a2[2][8];
#pragma unroll
        for (int i = 0; i < 2; ++i)
#pragma unroll
            for (int j = 0; j < 8; ++j) a2[i][j] = (f4v){0.f, 0.f, 0.f, 0.f};
#pragma unroll
        for (int ks = 0; ks < 4; ++ks) {
            s8v af[2], bfr[8];
#pragma unroll
            for (int i = 0; i < 2; ++i) af[i] = *(const s8v*)(Qs + (wave * 32 + i * 16 + l15) * QP + ks * 32 + gq * 8);
#pragma unroll
            for (int j = 0; j < 8; ++j) bfr[j] = *(const s8v*)(Ks + (j * 16 + l15) * QP + ks * 32 + gq * 8);
            __builtin_amdgcn_s_setprio(1);
#pragma unroll
            for (int i = 0; i < 2; ++i)
#pragma unroll
                for (int j = 0; j < 8; ++j) a2[i][j] = MFMA16(bfr[j], af[i], a2[i][j]);
            __builtin_amdgcn_s_setprio(0);
        }
        __syncthreads();
#pragma unroll
        for (int i = 0; i < 2; ++i)
#pragma unroll
            for (int j = 0; j < 8; ++j) *(f4v*)(Sf + (wave * 32 + i * 16 + l15) * SP + j * 16 + gq * 4) = a2[i][j];
        __syncthreads();
        {
            const int row = tid >> 1, half = tid & 1;
            const float* sr = Sf + row * SP;
            unsigned L[16];
#pragma unroll
            for (int ch = 0; ch < 4; ++ch) {
                unsigned C[16];
#pragma unroll
                for (int i4 = 0; i4 < 4; ++i4) {
                    const int col = half * 64 + ch * 16 + i4 * 4;
                    const f4v s4 = *(const f4v*)(sr + col);
#pragma unroll
                    for (int q = 0; q < 4; ++q) C[i4 * 4 + q] = (f2ord(s4[q]) & ~127u) | (unsigned)(col + q);
                }
                bitonic_sort16(C);
                if (ch == 0) {
#pragma unroll
                    for (int i = 0; i < 16; ++i) L[i] = C[i];
                } else {
#pragma unroll
                    for (int i = 0; i < 16; ++i) L[i] = max(L[i], C[15 - i]);
                    bitonic_merge16(L);
                }
            }
            {
                unsigned Pn[16];
#pragma unroll
                for (int i = 0; i < 16; ++i) Pn[i] = __shfl_xor(L[i], 1);
#pragma unroll
                for (int i = 0; i < 16; ++i) L[i] = max(L[i], Pn[15 - i]);
                bitonic_merge16(L);
            }
            if (half == 0) {
                const size_t r = (size_t)bb * TB + jt + row;
                float sv[16];
#pragma unroll
                for (int i = 0; i < 16; ++i) sv[i] = sr[L[i] & 127u];
                float* so = stop + (r * 16 + hp) * 16;
#pragma unroll
                for (int i = 0; i < 4; ++i) *(float4*)(so + i * 4) = make_float4(sv[i * 4], sv[i * 4 + 1], sv[i * 4 + 2], sv[i * 4 + 3]);
                u4v iw;
#pragma unroll
                for (int i = 0; i < 4; ++i) iw[i] = (L[i * 4] & 127u) | ((L[i * 4 + 1] & 127u) << 8) | ((L[i * 4 + 2] & 127u) << 16) | ((L[i * 4 + 3] & 127u) << 24);
                *(u4v*)(itop + (r * 16 + hp) * 16) = iw;
            }
        }
        __syncthreads();
    }
}


__device__ __forceinline__ unsigned cvtpk(float lo, float hi) { f32x2_t v = {lo, hi}; return __builtin_bit_cast(unsigned, __builtin_convertvector(v, bf16x2_t)); }
__device__ __forceinline__ float max3f(float a, float b, float c) { float r; asm("v_max3_f32 %0, %1, %2, %3" : "=v"(r) : "v"(a), "v"(b), "v"(c)); return r; }
constexpr int ATL = 64 * GP;
constexpr int BIAS_OFF_B = 66048, LRUW_OFF_B = 49152;

template <int KIND>
__device__ __forceinline__ void attn_item_fast(const Params& p, int l, int b, int hsel, int blk, bool ctxq, bf16* lds, const float* biasLds) {
    constexpr int kind = KIND;
    const int tid = tid_op(), lane = tid & 63, wave = __builtin_amdgcn_readfirstlane(tid >> 6), l15 = lane & 15, gq = lane >> 4;
    const bf16* Z = (const bf16*)(p.ws + WS_Z) + (size_t)b * TB * ZP;
    int head, j0;
    if (kind == 2) { head = hsel; j0 = ctxq ? wave * 64 : LC + (blk * 4 + wave) * 64; }
    else { head = hsel * 2 + (wave >> 1); j0 = (ctxq ? 0 : LC) + blk * 128 + (wave & 1) * 64; }
    const int kvh = (kind == 2) ? head : hsel;
    const int qcol = (kind == 0 ? ZQA : kind == 1 ? ZQB : ZQN) + head * 64;
    const int kcol = (kind == 0 ? ZKA : kind == 1 ? ZKB : ZKN) + kvh * 64;
    const bf16* Vg = (kind == 0) ? (const bf16*)(p.ws + WS_VTA) + ((size_t)(b * 2 + kvh) * 64) * TB
                   : (kind == 1) ? (const bf16*)(p.ws + WS_VTB) + ((size_t)(b * 2 + kvh) * 64) * TB
                                 : (const bf16*)(p.ws + WS_VTN) + ((size_t)(b * 4 + kvh) * 64) * TB;
    const bf16* Kg = Z + kcol;
    s8v qf[4][2];
#pragma unroll
    for (int nt = 0; nt < 4; ++nt)
#pragma unroll
        for (int ks = 0; ks < 2; ++ks) qf[nt][ks] = *(const s8v*)(Z + (size_t)(j0 + nt * 16 + l15) * ZP + qcol + ks * 32 + gq * 8);
#pragma unroll
    for (int nt = 0; nt < 4; ++nt)
#pragma unroll
        for (int ks = 0; ks < 2; ++ks) asm volatile("" : "+v"(qf[nt][ks]));
    int ntile = 4, locbase = 0;
    if (!ctxq) {
        if (kind == 1) { ntile = 132; }
        else if (kind == 0) { int lo = (blk - 1) * 128, hi = (blk + 2) * 128; lo = lo < 0 ? 0 : lo; hi = hi > SEQ ? SEQ : hi; ntile = 4 + ((hi - lo) >> 6); locbase = LC + lo; }
        else { int lo = blk * 4 - 4; lo = lo < 0 ? 0 : (lo > 120 ? 120 : lo); int hi = blk * 4 + 3 - 4; hi = hi < 0 ? 0 : (hi > 120 ? 120 : hi); hi += 7; ntile = 4 + (hi - lo + 1); locbase = LC + lo * 64; }
    }
    const int qt0 = j0 - LC;
    int kr0w = (qt0 >> 6) - 4; kr0w = kr0w < 0 ? 0 : (kr0w > 120 ? 120 : kr0w);
    f4v ot[4][4];
    float mrun[4], ls[4];
#pragma unroll
    for (int i = 0; i < 4; ++i) {
        mrun[i] = -1e30f; ls[i] = 0.f;
#pragma unroll
        for (int j = 0; j < 4; ++j) ot[i][j] = (f4v){0.f, 0.f, 0.f, 0.f};
    }
    float negc = 0.f;
    if (KIND == 1) {
        const float gqm = wave_max(fabsf(p.qn_g[l * 64 + lane])), gkm = wave_max(fabsf(p.kn_g[l * 64 + lane]));
        negc = -8.f * gqm * gkm * 1.0002f * 1.4426950408889634f;
    }
    const int lr = tid >> 3, lc = tid & 7;
    const int vpos = (lc >> 2) * 32 + (lc & 1) * 16 + ((lc >> 1) & 1) * 4;
    u4v rk[2], rv[2];
    {
        const int kb0 = 0;
#pragma unroll
        for (int c = 0; c < 2; ++c) {
            rk[c] = *(const u4v*)(Kg + (size_t)(kb0 + lr + 32 * c) * ZP + lc * 8);
            rv[c] = *(const u4v*)(Vg + (size_t)(lr + 32 * c) * TB + kb0 + lc * 8);
        }
#pragma unroll
        for (int c = 0; c < 2; ++c) {
            *(u4v*)(lds + (lr + 32 * c) * GP + lc * 8) = rk[c];
            bf16* vd = lds + ATL + (lr + 32 * c) * GP + vpos;
            *(uint2*)vd = make_uint2(rv[c][0], rv[c][1]); *(uint2*)(vd + 8) = make_uint2(rv[c][2], rv[c][3]);
        }
    }
    __syncthreads();
#pragma unroll 1
    for (int i = 0; i < ntile; ++i) {
        const int buf = i & 1;
        if (i + 1 < ntile) {
            const int kb1 = (kind == 1 || ctxq || i + 1 < 4) ? (i + 1) * 64 : locbase + (i + 1 - 4) * 64;
#pragma unroll
            for (int c = 0; c < 2; ++c) {
                rk[c] = *(const u4v*)(Kg + (size_t)(kb1 + lr + 32 * c) * ZP + lc * 8);
                rv[c] = *(const u4v*)(Vg + (size_t)(lr + 32 * c) * TB + kb1 + lc * 8);
            }
        }
        bool use = true; int maskmode = 0; int tt0 = 0, krow = 0;
        if (!ctxq && i >= 4) {
            if (kind == 0) { tt0 = locbase - LC + (i - 4) * 64; use = (tt0 + 63 >= qt0 - 128) && (tt0 <= qt0 + 63 + 128); maskmode = 1; }
            else if (kind == 2) { krow = ((locbase - LC) >> 6) + (i - 4); use = (krow >= kr0w) && (krow < kr0w + 8); maskmode = 2; }
        }
        if (use) {
            const bf16* Ks = lds + buf * 2 * ATL;
            const bf16* Vs = Ks + ATL;
            const float* bt = biasLds + head * 465 + (krow - (qt0 >> 6) + 7) * 31 + 15;
#pragma unroll 1
            for (int hk = 0; hk < 2; ++hk) {
                f4v st[2][4];
#pragma unroll
                for (int a = 0; a < 2; ++a)
#pragma unroll
                    for (int c = 0; c < 4; ++c) st[a][c] = (f4v){negc, negc, negc, negc};
#pragma unroll
                for (int ks = 0; ks < 2; ++ks) {
                    s8v kf[2];
#pragma unroll
                    for (int mt = 0; mt < 2; ++mt) kf[mt] = *(const s8v*)(Ks + ((hk * 2 + mt) * 16 + l15) * GP + ks * 32 + gq * 8);
                    __builtin_amdgcn_s_setprio(1);
#pragma unroll
                    for (int mt = 0; mt < 2; ++mt)
#pragma unroll
                        for (int nt = 0; nt < 4; ++nt) st[mt][nt] = MFMA16(kf[mt], qf[nt][ks], st[mt][nt]);
                    __builtin_amdgcn_s_setprio(0);
                }
                if (maskmode == 1) {
#pragma unroll
                    for (int nt = 0; nt < 4; ++nt) {
                        const int qt = qt0 + nt * 16 + l15;
#pragma unroll
                        for (int mt = 0; mt < 2; ++mt)
#pragma unroll
                            for (int q = 0; q < 4; ++q) { int dl = tt0 + (hk * 2 + mt) * 16 + gq * 4 + q - qt; if (dl > 128 || dl < -128) st[mt][nt][q] = -1e30f; }
                    }
                } else if (maskmode == 2) {
#pragma unroll
                    for (int nt = 0; nt < 4; ++nt) {
                        const int qc = nt * 16 + l15;
                        int cs0 = qc - 8; cs0 = cs0 < 0 ? 0 : (cs0 > 48 ? 48 : cs0);
#pragma unroll
                        for (int mt = 0; mt < 2; ++mt)
#pragma unroll
                            for (int q = 0; q < 4; ++q) {
                                const int kc = (hk * 2 + mt) * 16 + gq * 4 + q;
                                int dc = kc - qc; dc = dc < -15 ? -15 : (dc > 15 ? 15 : dc);
                                const bool ok = (kc >= cs0) && (kc < cs0 + 16);
                                st[mt][nt][q] = ok ? st[mt][nt][q] + bt[dc] : -1e30f;
                            }
                    }
                }
                s8v pf[4];
#pragma unroll
                for (int nt = 0; nt < 4; ++nt) {
                    float psum = 0.f;
                    if (KIND == 1) {
#pragma unroll
                        for (int mt = 0; mt < 2; ++mt)
#pragma unroll
                            for (int q = 0; q < 4; ++q) { float pv = __builtin_amdgcn_exp2f(st[mt][nt][q]); st[mt][nt][q] = pv; psum += pv; }
                    } else {
                        float mx = max3f(max3f(st[0][nt][0], st[0][nt][1], st[0][nt][2]), max3f(st[0][nt][3], st[1][nt][0], st[1][nt][1]), max3f(st[1][nt][2], st[1][nt][3], mrun[nt]));
                        mx = max3f(mx, __shfl_xor(mx, 16), mx); mx = max3f(mx, __shfl_xor(mx, 32), mx);
                        if (__any(mx > mrun[nt] + 8.f)) {
                            const float mnew = fmaxf(mrun[nt], mx);
                            const float alpha = __expf(mrun[nt] - mnew);
                            mrun[nt] = mnew;
                            ls[nt] *= alpha;
#pragma unroll
                            for (int dt = 0; dt < 4; ++dt) ot[dt][nt] *= alpha;
                        }
                        const float mcur = mrun[nt];
#pragma unroll
                        for (int mt = 0; mt < 2; ++mt)
#pragma unroll
                            for (int q = 0; q < 4; ++q) { float pv = __expf(st[mt][nt][q] - mcur); st[mt][nt][q] = pv; psum += pv; }
                    }
                    ls[nt] += psum;
                    u4v w;
                    w[0] = cvtpk(st[0][nt][0], st[0][nt][1]); w[1] = cvtpk(st[0][nt][2], st[0][nt][3]);
                    w[2] = cvtpk(st[1][nt][0], st[1][nt][1]); w[3] = cvtpk(st[1][nt][2], st[1][nt][3]);
                    pf[nt] = __builtin_bit_cast(s8v, w);
                }
                s8v vf[4];
#pragma unroll
                for (int dt = 0; dt < 4; ++dt) {
                    vf[dt] = *(const s8v*)(Vs + (dt * 16 + l15) * GP + hk * 32 + gq * 8);
                }
                __builtin_amdgcn_s_setprio(1);
#pragma unroll
                for (int dt = 0; dt < 4; ++dt)
#pragma unroll
                    for (int nt = 0; nt < 4; ++nt) ot[dt][nt] = MFMA16(vf[dt], pf[nt], ot[dt][nt]);
                __builtin_amdgcn_s_setprio(0);
            }
        }
        if (i + 1 < ntile) {
            bf16* kd = lds + (buf ^ 1) * 2 * ATL;
#pragma unroll
            for (int c = 0; c < 2; ++c) {
                *(u4v*)(kd + (lr + 32 * c) * GP + lc * 8) = rk[c];
                bf16* vd = kd + ATL + (lr + 32 * c) * GP + vpos;
                *(uint2*)vd = make_uint2(rv[c][0], rv[c][1]); *(uint2*)(vd + 8) = make_uint2(rv[c][2], rv[c][3]);
            }
        }
        lds_barrier();
    }
    const float sk = (kind == 0) ? p.attn_sink[l * 4 + head] : 0.f;
#pragma unroll
    for (int nt = 0; nt < 4; ++nt) {
        float lsum = ls[nt];
        lsum += __shfl_xor(lsum, 16); lsum += __shfl_xor(lsum, 32);
        float scale = 1.f;
        if (kind == 0) { const float mx = fmaxf(mrun[nt], sk), a = __expf(mrun[nt] - mx); lsum = lsum * a + __expf(sk - mx); scale = a; }
        const float inv = scale / lsum;
        bf16* y = (bf16*)(p.ws + WS_Y) + ((size_t)b * TB + j0 + nt * 16 + l15) * D + kind * 256 + head * 64;
#pragma unroll
        for (int dt = 0; dt < 4; ++dt) {
            uint2 w; w.x = cvtpk(ot[dt][nt][0] * inv, ot[dt][nt][1] * inv); w.y = cvtpk(ot[dt][nt][2] * inv, ot[dt][nt][3] * inv);
            *(uint2*)(y + dt * 16 + gq * 4) = w;
        }
    }
}


constexpr int LX_OFF = 0, LU_OFF = 8704, LA_OFF = 17920, LB_OFF = 34304, LCW_OFF = 50688, LWX_OFF = 51968;
template <int STP>
__device__ __forceinline__ void seg_aggr(const float* Aa, const float* Bb, int a0, float& ap, float& hl) {
#pragma unroll
    for (int half = 0; half < 2; ++half) {
        float av[8], bv[8];
#pragma unroll
        for (int i = 0; i < 8; ++i) { av[i] = Aa[a0 + (half * 8 + i) * STP]; bv[i] = Bb[a0 + (half * 8 + i) * STP]; }
#pragma unroll
        for (int i = 0; i < 8; ++i) { hl = av[i] * hl + bv[i]; ap *= av[i]; }
    }
}
template <int STP>
__device__ __forceinline__ void seg_apply(float* Aa, float* Bb, int a0, float hin, float ain) {
#pragma unroll
    for (int half = 0; half < 2; ++half) {
        float av[8], bv[8];
#pragma unroll
        for (int i = 0; i < 8; ++i) { av[i] = Aa[a0 + (half * 8 + i) * STP]; bv[i] = Bb[a0 + (half * 8 + i) * STP]; }
#pragma unroll
        for (int i = 0; i < 8; ++i) { hin = av[i] * hin + bv[i]; ain *= av[i]; av[i] = hin; bv[i] = ain; }
#pragma unroll
        for (int i = 0; i < 8; ++i) { Aa[a0 + (half * 8 + i) * STP] = av[i]; Bb[a0 + (half * 8 + i) * STP] = bv[i]; }
    }
}
constexpr int LRU_NSEG = 6, LRU_SEGC = 22;
constexpr int LRU_ITEMS = 16 * 2 * LRU_NSEG;
__device__ __forceinline__ void lru_item_fast(const Params& p, int l, int b, int n, int dir, int seg, unsigned char* smem) {
    const int tid = tid_op(), lane = tid & 63, wave = __builtin_amdgcn_readfirstlane(tid >> 6), l15 = lane & 15, gq = lane >> 4;
    bf16* Xs = (bf16*)(smem + LX_OFF);
    bf16* Us = (bf16*)(smem + LU_OFF);
    float* Aa = (float*)(smem + LA_OFF);
    float* Bb = (float*)(smem + LB_OFF);
    float* CW = (float*)(smem + LCW_OFF);
    float* SAg = (float*)(smem + LWX_OFF + 9216);
    float* SBg = SAg + 256;
    bf16* WXs = (bf16*)(smem + LWX_OFF);
    const bf16* Z = (const bf16*)(p.ws + WS_Z) + (size_t)b * TB * ZP;
    float* HL = (float*)(p.ws + (dir ? WS_H : WS_HF)) + ((size_t)b * TB) * 256 + n * 64;
    float* AC = HL + (size_t)M * 256;
    for (int i = tid; i < 320; i += 256) { int q = i >> 6, c = i & 63; CW[i] = (q < 4) ? p.conv_w[(l * 4 + q) * 256 + n * 64 + c] : p.conv_b[l * 256 + n * 64 + c]; }
    const int ptok = tid >> 2, ppart = tid & 3;
    const int lr = tid >> 3, lc = tid & 7;
    const bf16* wbase = (const bf16*)(p.ws + WS_LRUW) + ((size_t)((l * 2 + dir) * 2) * 4 + n) * 4096;
    s8v wfa[4][2];
#pragma unroll
    for (int nj = 0; nj < 4; ++nj)
#pragma unroll
        for (int ks = 0; ks < 2; ++ks) wfa[nj][ks] = *(const s8v*)(wbase + (nj * 16 + l15) * 64 + ks * 32 + gq * 8);
#pragma unroll
    for (int i = 0; i < 2; ++i) { int cidx = tid + i * 256, row = cidx >> 3, kc = cidx & 7; *(u4v*)(WXs + row * GP + kc * 8) = *(const u4v*)(wbase + (size_t)4 * 4096 + row * 64 + kc * 8); }
    float cba[4], cbx[4], csp[4];
#pragma unroll
    for (int nj = 0; nj < 4; ++nj) {
        const int ch = n * 64 + nj * 16 + l15;
        cba[nj] = p.lru_ba[(l * 2 + dir) * 256 + ch]; cbx[nj] = p.lru_bx[(l * 2 + dir) * 256 + ch];
        const float lam = p.lru_lam[(l * 2 + dir) * 256 + ch];
        csp[nj] = (lam > 15.f) ? __expf(-lam) : log1pf(__expf(-lam));
    }
#pragma unroll
    for (int nj = 0; nj < 4; ++nj) {
#pragma unroll
        for (int ks = 0; ks < 2; ++ks) asm volatile("" : "+v"(wfa[nj][ks]));
        asm volatile("" : "+v"(cba[nj]), "+v"(cbx[nj]), "+v"(csp[nj]));
    }
    float h = 0.f, ain = 1.f;
    u4v rx[3];
    const int cbeg = seg * LRU_SEGC;
    {
        const int c = cbeg;
        const int jlo = dir ? (c < 4 ? LC - 64 - c * 64 : TB + LC - 64 - c * 64) : c * 64;
        const int lo = (jlo < LC) ? 0 : LC, hi = (jlo < LC) ? LC : TB;
#pragma unroll
        for (int i = 0; i < 3; ++i) { int row = lr + 32 * i, jj = jlo - 2 + row; rx[i] = (row < 67 && jj >= lo && jj < hi) ? *(const u4v*)(Z + (size_t)jj * ZP + ZXR + n * 64 + lc * 8) : (u4v){0u, 0u, 0u, 0u}; }
#pragma unroll
        for (int i = 0; i < 3; ++i) if (lr + 32 * i < 68) *(u4v*)(Xs + (lr + 32 * i) * 64 + lc * 8) = rx[i];
    }
#pragma unroll 1
    for (int c = cbeg; c < cbeg + LRU_SEGC; ++c) {
        const int jlo = dir ? (c < 4 ? LC - 64 - c * 64 : TB + LC - 64 - c * 64) : c * 64;
        if (c + 1 < cbeg + LRU_SEGC) {
            const int c1 = c + 1;
            const int jn = dir ? (c1 < 4 ? LC - 64 - c1 * 64 : TB + LC - 64 - c1 * 64) : c1 * 64;
            const int lo = (jn < LC) ? 0 : LC, hi = (jn < LC) ? LC : TB;
#pragma unroll
            for (int i = 0; i < 3; ++i) { int row = lr + 32 * i, jj = jn - 2 + row; rx[i] = (row < 67 && jj >= lo && jj < hi) ? *(const u4v*)(Z + (size_t)jj * ZP + ZXR + n * 64 + lc * 8) : (u4v){0u, 0u, 0u, 0u}; }
        }
        lds_barrier();
        {
            float u[16];
#pragma unroll
            for (int i = 0; i < 16; ++i) u[i] = CW[256 + ppart * 16 + i];
#pragma unroll
            for (int q = 0; q < 4; ++q) {
                const u4v x0 = *(const u4v*)(Xs + (ptok + q) * 64 + ppart * 16), x1 = *(const u4v*)(Xs + (ptok + q) * 64 + ppart * 16 + 8);
#pragma unroll
                for (int i = 0; i < 4; ++i) {
                    u[2 * i] += CW[q * 64 + ppart * 16 + 2 * i] * lo16(x0[i]); u[2 * i + 1] += CW[q * 64 + ppart * 16 + 2 * i + 1] * hi16(x0[i]);
                    u[8 + 2 * i] += CW[q * 64 + ppart * 16 + 8 + 2 * i] * lo16(x1[i]); u[8 + 2 * i + 1] += CW[q * 64 + ppart * 16 + 8 + 2 * i + 1] * hi16(x1[i]);
                }
            }
            u4v w0, w1;
#pragma unroll
            for (int i = 0; i < 4; ++i) { w0[i] = pk2(u[2 * i], u[2 * i + 1]); w1[i] = pk2(u[8 + 2 * i], u[8 + 2 * i + 1]); }
            *(u4v*)(Us + ptok * GP + ppart * 16) = w0; *(u4v*)(Us + ptok * GP + ppart * 16 + 8) = w1;
        }
        lds_barrier();
        {
            f4v ga[4], gx[4];
#pragma unroll
            for (int nj = 0; nj < 4; ++nj) { ga[nj] = (f4v){0.f, 0.f, 0.f, 0.f}; gx[nj] = (f4v){0.f, 0.f, 0.f, 0.f}; }
#pragma unroll
            for (int ks = 0; ks < 2; ++ks) {
                const s8v af = *(const s8v*)(Us + (wave * 16 + l15) * GP + ks * 32 + gq * 8);
#pragma unroll
                for (int nj = 0; nj < 4; ++nj) { ga[nj] = MFMA16(af, wfa[nj][ks], ga[nj]); gx[nj] = MFMA16(af, *(const s8v*)(WXs + (nj * 16 + l15) * GP + ks * 32 + gq * 8), gx[nj]); }
            }
#pragma unroll
            for (int nj = 0; nj < 4; ++nj)
#pragma unroll
                for (int q = 0; q < 4; ++q) {
                    const int tok = wave * 16 + gq * 4 + q, ch = nj * 16 + l15;
                    const float uu = bf2f(Us[tok * GP + ch]);
                    const float rg = __builtin_amdgcn_rcpf(1.f + __expf(-(ga[nj][q] + cba[nj]))), ig = __builtin_amdgcn_rcpf(1.f + __expf(-(gx[nj][q] + cbx[nj])));
                    const float av_ = __expf(-8.f * rg * csp[nj]);
                    Aa[tok * 64 + ch] = av_;
                    Bb[tok * 64 + ch] = __builtin_amdgcn_sqrtf(fmaxf(1.f - av_ * av_, 0.f)) * (ig * uu);
                }
        }
        lds_barrier();
        {
            const int tb = dir ? (63 - wave * 16) : wave * 16;
            const int a0 = tb * 64 + lane;
            float ap = 1.f, hl = 0.f;
            if (dir) seg_aggr<-64>(Aa, Bb, a0, ap, hl); else seg_aggr<64>(Aa, Bb, a0, ap, hl);
            SAg[wave * 64 + lane] = ap; SBg[wave * 64 + lane] = hl;
            lds_barrier();
            float hin = h, ainw = ain, hc = h, ac = ain;
#pragma unroll
            for (int w2 = 0; w2 < 4; ++w2) { if (w2 == wave) { hin = hc; ainw = ac; } const float sa = SAg[w2 * 64 + lane]; hc = sa * hc + SBg[w2 * 64 + lane]; ac *= sa; }
            h = hc; ain = ac;
            if (dir) seg_apply<-64>(Aa, Bb, a0, hin, ainw); else seg_apply<64>(Aa, Bb, a0, hin, ainw);
        }
        lds_barrier();
        {
#pragma unroll
            for (int i = 0; i < 4; ++i) {
                *(f4v*)(HL + (size_t)(jlo + ptok) * 256 + ppart * 16 + i * 4) = *(const f4v*)(Aa + ptok * 64 + ppart * 16 + i * 4);
                *(f4v*)(AC + (size_t)(jlo + ptok) * 256 + ppart * 16 + i * 4) = *(const f4v*)(Bb + ptok * 64 + ppart * 16 + i * 4);
            }
        }
        if (c + 1 < cbeg + LRU_SEGC) {
#pragma unroll
            for (int i = 0; i < 3; ++i) if (lr + 32 * i < 68) *(u4v*)(Xs + (lr + 32 * i) * 64 + lc * 8) = rx[i];
        }
    }
    if (wave == 0) {
        float* ag = (float*)(p.ws + WS_AGG) + ((size_t)(((b * 4 + n) * 2 + dir) * LRU_NSEG + seg)) * 128;
        ag[lane] = h; ag[64 + lane] = ain;
    }
    lds_barrier();
}

__device__ __forceinline__ void phase_lru_combine(const Params& p, int l) {
    const int tid = tid_op();
    const float* HLb = (const float*)(p.ws + WS_HF);
    const float* HLb1 = (const float*)(p.ws + WS_H);
    const float* AG = (const float*)(p.ws + WS_AGG);
    const bf16* Zb = (const bf16*)(p.ws + WS_Z);
    bf16* Yb = (bf16*)(p.ws + WS_Y);
    for (int u = blockIdx.x * 256 + tid; u < M * 32; u += gridDim.x * 256) {
        const int r = u >> 5, g = u & 31, b = r / TB, j = r - b * TB;
        if (l == 1 && j < LC) continue;
        const int ch0 = g * 8, n = ch0 >> 6, cl = ch0 & 63;
        const int seg0 = (j >> 6) / LRU_SEGC;
        const int c1 = (j < LC) ? 3 - (j >> 6) : 135 - (j >> 6);
        const int seg1 = c1 / LRU_SEGC;
        float car0[8], car1[8];
#pragma unroll
        for (int i = 0; i < 8; ++i) { car0[i] = 0.f; car1[i] = 0.f; }
        for (int s = 0; s < seg0; ++s) {
            const float* ag = AG + ((size_t)(((b * 4 + n) * 2 + 0) * LRU_NSEG + s)) * 128 + cl;
#pragma unroll
            for (int i = 0; i < 8; ++i) car0[i] = ag[64 + i] * car0[i] + ag[i];
        }
        for (int s = 0; s < seg1; ++s) {
            const float* ag = AG + ((size_t)(((b * 4 + n) * 2 + 1) * LRU_NSEG + s)) * 128 + cl;
#pragma unroll
            for (int i = 0; i < 8; ++i) car1[i] = ag[64 + i] * car1[i] + ag[i];
        }
        const size_t ro = (size_t)r * 256 + ch0;
        const f4v h0a = *(const f4v*)(HLb + ro), h0b = *(const f4v*)(HLb + ro + 4);
        const f4v a0a = *(const f4v*)(HLb + (size_t)M * 256 + ro), a0b = *(const f4v*)(HLb + (size_t)M * 256 + ro + 4);
        const f4v h1a = *(const f4v*)(HLb1 + ro), h1b = *(const f4v*)(HLb1 + ro + 4);
        const f4v a1a = *(const f4v*)(HLb1 + (size_t)M * 256 + ro), a1b = *(const f4v*)(HLb1 + (size_t)M * 256 + ro + 4);
        const u4v xg = *(const u4v*)(Zb + (size_t)r * ZP + ZXG + ch0);
        float y[8];
#pragma unroll
        for (int i = 0; i < 4; ++i) {
            y[i] = (h0a[i] + a0a[i] * car0[i]) + (h1a[i] + a1a[i] * car1[i]);
            y[4 + i] = (h0b[i] + a0b[i] * car0[4 + i]) + (h1b[i] + a1b[i] * car1[4 + i]);
        }
        u4v o;
#pragma unroll
        for (int i = 0; i < 4; ++i) o[i] = pk2(y[2 * i] * gelu_t(lo16(xg[i])), y[2 * i + 1] * gelu_t(hi16(xg[i])));
        *(u4v*)(Yb + (size_t)r * D + 768 + ch0) = o;
    }
}

__device__ __forceinline__ void phase_mixers_fast(const Params& p, int l, unsigned char* smem, int* s_item, int ctr_off) {
    const int tid = threadIdx.x;
    float* biasLds = (float*)(smem + BIAS_OFF_B);
    for (int i = tid; i < 4 * 465; i += 256) biasLds[i] = p.na_bias[(size_t)l * 4 * 465 + i];
    unsigned* ctr = (unsigned*)(p.ws + WS_CTL) + l + ctr_off;
    const int nctx = (l == 0) ? 48 : 0;
    const int total = 512 + LRU_ITEMS + 2 * 512 + nctx;
    __syncthreads();
    while (true) {
        if (tid == 0) *s_item = (int)atomicAdd(ctr, 1u);
        __syncthreads();
        const int item = *s_item;
        __syncthreads();
        if (item >= total) break;
        if (item < 512) {
            const int b = item >> 7, rem = item & 127;
            attn_item_fast<1>(p, l, b, rem >> 6, rem & 63, false, (bf16*)smem, biasLds);
        } else if (item < 512 + LRU_ITEMS) {
            const int v = item - 512;
            const int seg = v % LRU_NSEG, w = v / LRU_NSEG;
            lru_item_fast(p, l, w >> 3, (w >> 1) & 3, w & 1, seg, smem);
        } else if (item < 512 + LRU_ITEMS + 1024) {
            const int v = item - 512 - LRU_ITEMS, idx = v & 511;
            const int b = idx >> 7, rem = idx & 127;
            if (v < 512) attn_item_fast<2>(p, l, b, rem >> 5, rem & 31, false, (bf16*)smem, biasLds);
            else attn_item_fast<0>(p, l, b, rem >> 6, rem & 63, false, (bf16*)smem, biasLds);
        } else {
            const int v = item - 512 - LRU_ITEMS - 1024, ko = v >> 4, rem = v & 15;
            const int kind = (ko == 0) ? 1 : (ko == 1 ? 0 : 2);
            const int b = rem >> 2, x = rem & 3;
            if (kind == 2) attn_item_fast<2>(p, l, b, x, 0, true, (bf16*)smem, biasLds);
            else if (kind == 1) attn_item_fast<1>(p, l, b, x >> 1, x & 1, true, (bf16*)smem, biasLds);
            else attn_item_fast<0>(p, l, b, x >> 1, x & 1, true, (bf16*)smem, biasLds);
        }
        __syncthreads();
    }
}

__device__ __forceinline__ void fp8x16_to_f32(const u4v w, float (&f)[16]) {
#pragma unroll
    for (int i = 0; i < 4; ++i) {
        const f2v lo = __builtin_amdgcn_cvt_pk_f32_fp8((int)w[i], false), hi = __builtin_amdgcn_cvt_pk_f32_fp8((int)w[i], true);
        f[i * 4] = lo[0]; f[i * 4 + 1] = lo[1]; f[i * 4 + 2] = hi[0]; f[i * 4 + 3] = hi[1];
    }
}
__device__ __forceinline__ float xch32(float v, int lane) {
    const unsigned b = __float_as_uint(v);
    const auto r = __builtin_amdgcn_permlane32_swap(b, b, false, false);
    return __uint_as_float((lane & 32) ? r[0] : r[1]);
}
__device__ __forceinline__ float xch16(float v, int lane) {
    const unsigned b = __float_as_uint(v);
    const auto r = __builtin_amdgcn_permlane16_swap(b, b, false, false);
    return __uint_as_float((lane & 16) ? r[0] : r[1]);
}
template <int CTRL>
__device__ __forceinline__ float dppf(float v) { return __uint_as_float((unsigned)__builtin_amdgcn_update_dpp(0, (int)__float_as_uint(v), CTRL, 0xF, 0xF, false)); }
__device__ __forceinline__ float xch8(float v) { return dppf<0x128>(v); }
__device__ __forceinline__ float xch4(float v) { return dppf<0x1B>(dppf<0x141>(v)); }
__device__ __forceinline__ float xch2(float v) { return dppf<0x4E>(v); }
__device__ __forceinline__ float xch1(float v) { return dppf<0xB1>(v); }

__device__ __forceinline__ void phase_peer(const Params& p, int l) {
    const int tidx = tid_op(), lane = tidx & 63, gw = blockIdx.x * 4 + __builtin_amdgcn_readfirstlane(tidx >> 6), nw = gridDim.x * 4;
    const bf16* H = (const bf16*)(p.ws + WS_H);
    const unsigned char* U = p.ws + WS_U + (size_t)l * NE * D;
    const unsigned char* V = p.ws + WS_V + (size_t)l * NE * D;
    const float* US = (const float*)(p.ws + WS_US) + (size_t)l * NE;
    const float* VS = (const float*)(p.ws + WS_VS) + (size_t)l * NE;
    const float* stop = (const float*)(p.ws + WS_STOP);
    const unsigned char* itop = p.ws + WS_ITOP;
    const float* modv = (const float*)(p.ws + WS_MOD);
    const int ci = (lane >= 16) + (lane >= 24) + (lane >= 29) + (lane >= 33) + (lane >= 36) + (lane >= 38) + (lane >= 40) + (lane >= 42)
                 + (lane >= 43) + (lane >= 44) + (lane >= 45) + (lane >= 46) + (lane >= 47) + (lane >= 48) + (lane >= 49);
    const int cpre = (ci == 0) ? 0 : (ci == 1) ? 16 : (ci == 2) ? 24 : (ci == 3) ? 29 : (ci == 4) ? 33 : (ci == 5) ? 36 : (ci == 6) ? 38 : (ci == 7) ? 40 : 34 + ci;
    const int cj = (lane - cpre) & 15;
    const bool cvalid = lane < 50;
    for (int r = gw; r < M; r += nw) {
        const int mi = mod_idx(r);
        if (l == 1 && mi == 4) continue;
        float hf[16];
        {
            const bf16* hrow = H + (size_t)r * D + lane * 16;
            const u4v h0 = *(const u4v*)hrow, h1 = *(const u4v*)(hrow + 8);
#pragma unroll
            for (int i = 0; i < 4; ++i) { hf[2 * i] = lo16(h0[i]); hf[2 * i + 1] = hi16(h0[i]); hf[8 + 2 * i] = lo16(h1[i]); hf[8 + 2 * i + 1] = hi16(h1[i]); }
        }
        float out[16];
#pragma unroll
        for (int i = 0; i < 16; ++i) out[i] = 0.f;
        float st_n = -3e38f; int it_n = 0;
        if (lane < 32) { st_n = stop[(size_t)r * 256 + lane]; it_n = itop[(size_t)r * 256 + lane]; }
#pragma unroll 1
        for (int hh = 0; hh < 8; ++hh) {
            const float st = st_n; const int it = it_n;
            if (hh + 1 < 8 && lane < 32) { st_n = stop[(size_t)r * 256 + (hh + 1) * 32 + lane]; it_n = itop[(size_t)r * 256 + (hh + 1) * 32 + lane]; }
            const float cand = cvalid ? __shfl(st, ci) + __shfl(st, 16 + cj) : -3e38f;
            const int ecand = __shfl(it, ci) * 128 + __shfl(it, 16 + cj);
            const unsigned key = (f2ord(cand) & ~63u) | (unsigned)(63 - lane);
            unsigned thr = 0u;
#pragma unroll
            for (int bit = 31; bit >= 0; --bit) {
                const unsigned t = thr | (1u << bit);
                if (__popcll(__ballot(key >= t)) >= 16) thr = t;
            }
            const bool sel = key >= thr;
            const unsigned long long selm = __ballot(sel);
            const unsigned long long m2 = sel ? selm : ~selm;
            const int rank = __builtin_amdgcn_mbcnt_hi((unsigned)(m2 >> 32), __builtin_amdgcn_mbcnt_lo((unsigned)m2, 0u));
            const int dst = sel ? rank : 16 + rank;
            const float smax = __uint_as_float(__builtin_amdgcn_readlane(__float_as_uint(cand), 0));
            const float mys = __uint_as_float(__builtin_amdgcn_ds_permute(dst * 4, __float_as_uint(cand)));
            const int e = __builtin_amdgcn_ds_permute(dst * 4, ecand);
            const float su = US[e], sv = VS[e];
            float ex = (lane < 16) ? __expf(mys - smax) : 0.f;
            float esum = ex;
            esum += xch8(esum); esum += xch4(esum); esum += xch2(esum); esum += xch1(esum);
            float gate = (lane < 16) ? ex / esum : 0.f;
            u4v ur[16], vr[16];
#pragma unroll
            for (int k = 0; k < 16; ++k) { const int ek = __builtin_amdgcn_readlane(e, k); ur[k] = *(const u4v*)(U + (size_t)ek * D + lane * 16); }
#pragma unroll
            for (int k = 0; k < 16; ++k) { const int ek = __builtin_amdgcn_readlane(e, k); vr[k] = *(const u4v*)(V + (size_t)ek * D + lane * 16); }
            float part[16];
#pragma unroll
            for (int k = 0; k < 16; ++k) {
                f2v a2 = {0.f, 0.f};
#pragma unroll
                for (int i = 0; i < 4; ++i) {
                    const f2v lo = __builtin_amdgcn_cvt_pk_f32_fp8((int)ur[k][i], false), hi = __builtin_amdgcn_cvt_pk_f32_fp8((int)ur[k][i], true);
                    a2 += lo * (f2v){hf[i * 4], hf[i * 4 + 1]};
                    a2 += hi * (f2v){hf[i * 4 + 2], hf[i * 4 + 3]};
                }
                part[k] = a2[0] + a2[1];
            }
            float q8[8], q4[4], q2[2], q1;
            { const bool hi = (lane & 32) != 0;
#pragma unroll
              for (int k = 0; k < 8; ++k) { float send = hi ? part[k] : part[k + 8], keep = hi ? part[k + 8] : part[k]; q8[k] = keep + xch32(send, lane); } }
            { const bool hi = (lane & 16) != 0;
#pragma unroll
              for (int k = 0; k < 4; ++k) { float send = hi ? q8[k] : q8[k + 4], keep = hi ? q8[k + 4] : q8[k]; q4[k] = keep + xch16(send, lane); } }
            { const bool hi = (lane & 8) != 0;
#pragma unroll
              for (int k = 0; k < 2; ++k) { float send = hi ? q4[k] : q4[k + 2], keep = hi ? q4[k + 2] : q4[k]; q2[k] = keep + xch8(send); } }
            { const bool hi = (lane & 4) != 0; float send = hi ? q2[0] : q2[1], keep = hi ? q2[1] : q2[0]; q1 = keep + xch4(send); }
            q1 += xch2(q1); q1 += xch1(q1);
            const int kk = (lane >> 2) & 15;
            const float coef = gelu_t(q1 * __shfl(su, kk)) * __shfl(gate, kk) * __shfl(sv, kk);
#pragma unroll
            for (int k = 0; k < 16; ++k) {
                const float ck = __uint_as_float(__builtin_amdgcn_readlane(__float_as_uint(coef), 4 * k));
                float vf[16];
                fp8x16_to_f32(vr[k], vf);
#pragma unroll
                for (int i = 0; i < 16; ++i) out[i] += ck * vf[i];
            }
        }
        float* xr = xs_row(p, r) + lane * 16;
        float xv[16];
#pragma unroll
        for (int i = 0; i < 4; ++i) { const float4 t = *(const float4*)(xr + i * 4); xv[i * 4] = t.x; xv[i * 4 + 1] = t.y; xv[i * 4 + 2] = t.z; xv[i * 4 + 3] = t.w; }
        const float* mv = modv + ((size_t)l * 5 + mi) * 6144;
#pragma unroll
        for (int i = 0; i < 16; ++i) xv[i] += mv[5120 + lane * 16 + i] * out[i];
        float ss = 0.f;
#pragma unroll
        for (int i = 0; i < 16; ++i) ss += xv[i] * xv[i];
        ss = wave_sum(ss);
        const float rstd = rsqrtf(ss * (1.f / 1024.f) + EPS);
        if (l == 0) {
#pragma unroll
            for (int i = 0; i < 4; ++i) *(float4*)(xr + i * 4) = make_float4(xv[i * 4], xv[i * 4 + 1], xv[i * 4 + 2], xv[i * 4 + 3]);
            const float* mv1 = modv + ((size_t)1 * 5 + mi) * 6144;
            const float* g = p.norm_mix + D;
            float o[16];
#pragma unroll
            for (int i = 0; i < 16; ++i) { const int e0 = lane * 16 + i; o[i] = xv[i] * rstd * g[e0] * (1.f + mv1[1024 + e0]) + mv1[e0]; }
            u4v w0, w1;
#pragma unroll
            for (int i = 0; i < 4; ++i) { w0[i] = pk2(o[2 * i], o[2 * i + 1]); w1[i] = pk2(o[8 + 2 * i], o[8 + 2 * i + 1]); }
            bf16* hrow = (bf16*)(p.ws + WS_H) + (size_t)r * D + lane * 16;
            *(u4v*)hrow = w0; *(u4v*)(hrow + 8) = w1;
        } else {
#pragma unroll
            for (int i = 0; i < 4; ++i) {
                const float4 g4 = *(const float4*)(p.norm_final + lane * 16 + i * 4);
                *(float4*)(xr + i * 4) = make_float4(xv[i * 4] * rstd * g4.x, xv[i * 4 + 1] * rstd * g4.y, xv[i * 4 + 2] * rstd * g4.z, xv[i * 4 + 3] * rstd * g4.w);
            }
        }
    }
}

__device__ __forceinline__ void grid_bar(unsigned* ctl, unsigned& gen) {
    __syncthreads();
    gen += 1;
    unsigned* arrive = ctl + 256;
    unsigned* release = ctl + 896;
    if (threadIdx.x == 0) {
        __threadfence();
        __hip_atomic_store(arrive + blockIdx.x, gen, __ATOMIC_RELAXED, __HIP_MEMORY_SCOPE_AGENT);
    }
    if (blockIdx.x == 0) {
        for (unsigned i = threadIdx.x; i < gridDim.x; i += 256)
            while (__hip_atomic_load(arrive + i, __ATOMIC_RELAXED, __HIP_MEMORY_SCOPE_AGENT) < gen) __builtin_amdgcn_s_sleep(1);
        __syncthreads();
        if (threadIdx.x == 0) __hip_atomic_store(release, gen, __ATOMIC_RELAXED, __HIP_MEMORY_SCOPE_AGENT);
    }
    if (threadIdx.x == 0) {
        while (__hip_atomic_load(release, __ATOMIC_RELAXED, __HIP_MEMORY_SCOPE_AGENT) < gen) __builtin_amdgcn_s_sleep(1);
        __threadfence();
    }
    __syncthreads();
}

#ifndef DUP_MASK
#define DUP_MASK 0
#endif
__global__ void __launch_bounds__(256, 2) fwd_megakernel(Params p) {
    __shared__ __attribute__((aligned(16))) unsigned char smem[SMEM_BYTES];
    float* lds = (float*)smem;
    __shared__ int s_item;
    cg::grid_group grid = cg::this_grid();
    unsigned* gbar = (unsigned*)(p.ws + WS_CTL);
    unsigned gtarget = 0;
    phase0(p, lds);
    grid.sync();
    if (DUP_MASK & 1) { phase0(p, lds); grid_bar(gbar, gtarget); }
    phase_rownorm(p, 0, 0);
    grid_bar(gbar, gtarget);
#pragma unroll 1
    for (int l = 0; l < 2; ++l) {
        phase_inproj_fast(p, l, (bf16*)smem);
        grid_bar(gbar, gtarget);
        if (DUP_MASK & 2) { phase_inproj_fast(p, l, (bf16*)smem); grid_bar(gbar, gtarget); }
        phase_mixers_fast(p, l, smem, &s_item, 0);
        grid_bar(gbar, gtarget);
        if (DUP_MASK & 4) { phase_mixers_fast(p, l, smem, &s_item, 2); grid_bar(gbar, gtarget); }
        phase_lru_combine(p, l);
        grid_bar(gbar, gtarget);
        phase_outproj_fast(p, l, (bf16*)smem);
        grid_bar(gbar, gtarget);
        if ((DUP_MASK & 32) && l == 0) { phase_outproj_fast(p, l, (bf16*)smem); grid_bar(gbar, gtarget); }
        phase_rownorm(p, l, 1);
        grid_bar(gbar, gtarget);
        if (DUP_MASK & 16) { phase_rownorm(p, l, 1); grid_bar(gbar, gtarget); }
        phase_peerq_fast(p, l, (bf16*)smem);
        grid_bar(gbar, gtarget);
        if (DUP_MASK & 8) { phase_peerq_fast(p, l, (bf16*)smem); grid_bar(gbar, gtarget); }
        phase_peer(p, l);
        if (l == 0) grid_bar(gbar, gtarget);
    }
}

extern "C" void kernel_launch(void* const* d_in, const int* in_sizes, int n_in, void* d_out, int out_size, void* d_ws, size_t ws_size, hipStream_t stream) {
    static int grid_blocks = 0;
    if (!grid_blocks) {
        int dev = 0, cus = 0, per_cu = 0;
        hipGetDevice(&dev);
        hipDeviceGetAttribute(&cus, hipDeviceAttributeMultiprocessorCount, dev);
        hipOccupancyMaxActiveBlocksPerMultiprocessor(&per_cu, fwd_megakernel, 256, 0);
        if (per_cu > 2) per_cu = 2;
        if (per_cu < 1) per_cu = 1;
        grid_blocks = cus * per_cu;
        if (grid_blocks > 512) grid_blocks = 512;
        if (ws_size < WS_END) fprintf(stderr, "kernel_launch: workspace too small: need %zu have %zu\n", (size_t)WS_END, ws_size);
    }
    Params p{};
    const float** pp = (const float**)&p;
    for (int i = 0; i < 26; ++i) pp[i] = (const float*)d_in[i];
    p.out = (float*)d_out;
    p.ws = (unsigned char*)d_ws;
    (void)hipMemsetAsync((char*)d_ws + WS_CTL, 0, 4096, stream);
    void* args[] = {&p};
    hipError_t e = hipLaunchCooperativeKernel((void*)fwd_megakernel, dim3(grid_blocks), dim3(256), args, 0, stream);
    if (e != hipSuccess) fprintf(stderr, "cooperative launch failed: %s (grid %d)\n", hipGetErrorString(e), grid_blocks);
}
```

```cpp
#include <hip/hip_runtime.h>
#include <hip/hip_cooperative_groups.h>
#include <cstdio>
#include <cstdint>
namespace cg = cooperative_groups;

typedef unsigned short bf16;
typedef __bf16 bf2_t __attribute__((ext_vector_type(2)));
typedef unsigned u4v __attribute__((ext_vector_type(4)));

constexpr int D = 1024, NB = 4, SEQ = 8192, LC = 256, TB = SEQ + LC  , M = NB * TB  ;
constexpr int DIN = 2304, ZP = 1792;
constexpr int NE = 16384;
constexpr int ZQA = 0, ZKA = 256, ZQB = 384, ZKB = 640, ZQN = 768, ZKN = 1024, ZXR = 1280, ZXG = 1536;
constexpr float EPS = 1e-6f;

constexpr size_t al(size_t x) { return (x + 255) & ~(size_t)255; }
constexpr size_t WS_CTL = 0;
constexpr size_t WS_WIN = 4096;
constexpr size_t WS_WOUT = WS_WIN + al((size_t)2 * DIN * D * 2);
constexpr size_t WS_WQ = WS_WOUT + al((size_t)2 * D * D * 2);
constexpr size_t WS_KEYS = WS_WQ + al((size_t)2 * 2048 * D * 2);
constexpr size_t WS_LRUW = WS_KEYS + al((size_t)2 * 2 * 128 * 128 * 2);
constexpr size_t WS_U = WS_LRUW + al((size_t)2 * 2 * 2 * 4 * 4096 * 2);
constexpr size_t WS_V = WS_U + al((size_t)2 * NE * D);
constexpr size_t WS_US = WS_V + al((size_t)2 * NE * D);
constexpr size_t WS_VS = WS_US + al((size_t)2 * NE * 4);
constexpr size_t WS_MOD = WS_VS + al((size_t)2 * NE * 4);
constexpr size_t WS_ROPE = WS_MOD + al((size_t)2 * 5 * 6144 * 4);
constexpr size_t WS_H = WS_ROPE + al((size_t)128 * 16 * 8);
constexpr size_t WS_Z = WS_H + al((size_t)M * D * 2);
constexpr size_t WS_VTA = WS_Z + al((size_t)M * ZP * 2);
constexpr size_t WS_VTB = WS_VTA + al((size_t)NB * 2 * 64 * TB * 2);
constexpr size_t WS_VTN = WS_VTB + al((size_t)NB * 2 * 64 * TB * 2);
constexpr size_t WS_Y = WS_VTN + al((size_t)NB * 4 * 64 * TB * 2);
constexpr size_t WS_HF = WS_Y + al((size_t)M * D * 2);
constexpr size_t WS_AGG = WS_HF + al((size_t)2 * M * 256 * 4);
constexpr size_t WS_XC = WS_AGG + al((size_t)16 * 2 * 12 * 2 * 64 * 4);
constexpr size_t WS_END = WS_XC + al((size_t)NB * LC * D * 4);
constexpr size_t WS_STOP = WS_Z;
constexpr size_t WS_ITOP = WS_Z + al((size_t)M * 256 * 4);

struct Params {
    const float *x, *c, *ctx, *c_ctx, *w_mod, *b_mod, *norm_mix, *norm_ffn, *w_in, *w_out, *attn_sink, *qn_g, *kn_g, *na_bias,
        *conv_w, *conv_b, *lru_wa, *lru_ba, *lru_wx, *lru_bx, *lru_lam, *peer_wq, *peer_keys, *peer_u, *peer_v, *norm_final;
    float* out;
    unsigned char* ws;
};

__device__ __forceinline__ float bf2f(bf16 v) { return __uint_as_float((unsigned)v << 16); }
__device__ __forceinline__ bf16 f2bf(float f) { unsigned u = __float_as_uint(f); return (bf16)((u + 0x7fffu + ((u >> 16) & 1u)) >> 16); }
typedef __bf16 bf16x2_t __attribute__((ext_vector_type(2)));
typedef float f32x2_t __attribute__((ext_vector_type(2)));
__device__ __forceinline__ unsigned pk2(float lo, float hi) { f32x2_t v = {lo, hi}; return __builtin_bit_cast(unsigned, __builtin_convertvector(v, bf16x2_t)); }
__device__ __forceinline__ float lo16(unsigned w) { return __uint_as_float(w << 16); }
__device__ __forceinline__ float hi16(unsigned w) { return __uint_as_float(w & 0xffff0000u); }
__device__ __forceinline__ float dot2(unsigned a, unsigned b, float c) { return __builtin_amdgcn_fdot2_f32_bf16(__builtin_bit_cast(bf2_t, a), __builtin_bit_cast(bf2_t, b), c, false); }
__device__ __forceinline__ float dot8(uint4 a, uint4 b, float c) { c = dot2(a.x, b.x, c); c = dot2(a.y, b.y, c); c = dot2(a.z, b.z, c); return dot2(a.w, b.w, c); }
__device__ __forceinline__ float wave_sum(float v) {
#pragma unroll
    for (int o = 32; o > 0; o >>= 1) v += __shfl_xor(v, o);
    return v;
}
__device__ __forceinline__ float wave_max(float v) {
#pragma unroll
    for (int o = 32; o > 0; o >>= 1) v = fmaxf(v, __shfl_xor(v, o));
    return v;
}
__device__ __forceinline__ float gelu_t(float x) { float u = 0.7978845608028654f * (x + 0.044715f * x * x * x); return x * __builtin_amdgcn_rcpf(1.f + __expf(-2.f * u)); }
__device__ __forceinline__ float sigmoidf_(float x) { return 1.f / (1.f + __expf(-x)); }

__device__ __forceinline__ int tid_op() { int t = threadIdx.x; asm volatile("" : "+v"(t)); return t; }

__device__ __forceinline__ void lds_barrier() { asm volatile("s_waitcnt lgkmcnt(0)\n\ts_barrier" ::: "memory"); }

__device__ __forceinline__ const float* in_row(const Params& p, int r) {
    int b = r / TB, j = r - b * TB;
    return (j < LC) ? p.ctx + ((size_t)b * LC + j) * D : p.x + ((size_t)b * SEQ + (j - LC)) * D;
}
__device__ __forceinline__ float* xs_row(const Params& p, int r) {
    int b = r / TB, j = r - b * TB;
    return (j < LC) ? (float*)(p.ws + WS_XC) + ((size_t)b * LC + j) * D : p.out + ((size_t)b * SEQ + (j - LC)) * D;
}
__device__ __forceinline__ int mod_idx(int r) { int b = r / TB, j = r - b * TB; return (j < LC) ? 4 : b; }

__device__ __forceinline__ void p0_mod(const Params& p, float* lds) {
    float* sv = lds;
    float* red = lds + 5 * 1024;
    const int tid = threadIdx.x, lane = tid & 63, wave = tid >> 6;
    for (int i = tid; i < 5 * 1024; i += 256) {
        int bi = i >> 10, k = i & 1023;
        float v = (bi < 4) ? p.c[bi * 1024 + k] : p.c_ctx[k];
        sv[i] = v / (1.f + __expf(-v));
    }
    __syncthreads();
    float* modv = (float*)(p.ws + WS_MOD);
    for (int it = blockIdx.x; it < 2 * 96; it += gridDim.x) {
        int l = it / 96, col = (it % 96) * 64 + lane;
        const float* w = p.w_mod + (size_t)l * D * 6144 + col;
        float a0 = 0, a1 = 0, a2 = 0, a3 = 0, a4 = 0;
        int k0 = wave * 256;
#pragma unroll 8
        for (int k = k0; k < k0 + 256; ++k) {
            float wv = w[(size_t)k * 6144];
            a0 += sv[k] * wv; a1 += sv[1024 + k] * wv; a2 += sv[2048 + k] * wv; a3 += sv[3072 + k] * wv; a4 += sv[4096 + k] * wv;
        }
        red[(wave * 5 + 0) * 64 + lane] = a0; red[(wave * 5 + 1) * 64 + lane] = a1; red[(wave * 5 + 2) * 64 + lane] = a2;
        red[(wave * 5 + 3) * 64 + lane] = a3; red[(wave * 5 + 4) * 64 + lane] = a4;
        __syncthreads();
        for (int i = tid; i < 320; i += 256) {
            int bi = i / 64, cl = i % 64;
            float s = red[(0 * 5 + bi) * 64 + cl] + red[(1 * 5 + bi) * 64 + cl] + red[(2 * 5 + bi) * 64 + cl] + red[(3 * 5 + bi) * 64 + cl];
            int cc = (it % 96) * 64 + cl;
            modv[((size_t)l * 5 + bi) * 6144 + cc] = s + p.b_mod[l * 6144 + cc];
        }
        __syncthreads();
    }
}
__device__ __forceinline__ void p0_transpose(const float* src, bf16* dst, int K, int N, int nmat, float* lds) {
    const int tid = threadIdx.x;
    const int tk = K / 64, tn = N / 64, per = tk * tn;
    for (int it = blockIdx.x; it < nmat * per; it += gridDim.x) {
        int mat = it / per, t = it % per, k0 = (t / tn) * 64, n0 = (t % tn) * 64;
        const float* s = src + (size_t)mat * K * N;
        bf16* d = dst + (size_t)mat * K * N;
        for (int i = tid; i < 4096; i += 256) { int kk = i >> 6, nn = i & 63; lds[kk * 65 + nn] = s[(size_t)(k0 + kk) * N + n0 + nn]; }
        __syncthreads();
        for (int i = tid; i < 4096; i += 256) { int nn = i >> 6, kk = i & 63; d[(size_t)(n0 + nn) * K + k0 + kk] = f2bf(lds[kk * 65 + nn]); }
        __syncthreads();
    }
}
__device__ __forceinline__ void p0_convert(const float* src, bf16* dst, size_t n) {
    size_t i = ((size_t)blockIdx.x * 256 + threadIdx.x) * 4, st = (size_t)gridDim.x * 256 * 4;
    for (; i < n; i += st) {
        float4 v = *(const float4*)(src + i);
        uint2 o; o.x = pk2(v.x, v.y); o.y = pk2(v.z, v.w);
        *(uint2*)(dst + i) = o;
    }
}

typedef float f2v __attribute__((ext_vector_type(2)));
__device__ __forceinline__ void p0_convert_fp8(const float* src, unsigned char* dst, float* scales, int nrows) {
    const int tidx = tid_op(), lane = tidx & 63, gw = blockIdx.x * 4 + __builtin_amdgcn_readfirstlane(tidx >> 6), nw = gridDim.x * 4;
    for (int r = gw; r < nrows; r += nw) {
        const float* row = src + (size_t)r * D + lane * 16;
        float v[16];
#pragma unroll
        for (int i = 0; i < 4; ++i) { float4 t = *(const float4*)(row + i * 4); v[i * 4] = t.x; v[i * 4 + 1] = t.y; v[i * 4 + 2] = t.z; v[i * 4 + 3] = t.w; }
        float am = 0.f;
#pragma unroll
        for (int i = 0; i < 16; ++i) am = fmaxf(am, fabsf(v[i]));
        am = wave_max(am);
        const float inv = (am > 0.f) ? 448.f / am : 1.f;
        u4v w;
#pragma unroll
        for (int i = 0; i < 4; ++i) {
            int t = 0;
            t = __builtin_amdgcn_cvt_pk_fp8_f32(v[i * 4] * inv, v[i * 4 + 1] * inv, t, false);
            t = __builtin_amdgcn_cvt_pk_fp8_f32(v[i * 4 + 2] * inv, v[i * 4 + 3] * inv, t, true);
            w[i] = (unsigned)t;
        }
        *(u4v*)(dst + (size_t)r * D + lane * 16) = w;
        if (lane == 0) scales[r] = (am > 0.f) ? am * (1.f / 448.f) : 1.f;
    }
}
__device__ __forceinline__ void phase0(const Params& p, float* lds) {
    p0_mod(p, lds);
    __syncthreads();
    p0_transpose(p.w_in, (bf16*)(p.ws + WS_WIN), D, DIN, 2, lds);
    p0_transpose(p.w_out, (bf16*)(p.ws + WS_WOUT), D, D, 2, lds);
    p0_transpose(p.peer_wq, (bf16*)(p.ws + WS_WQ), D, 2048, 2, lds);
    for (int g = 0; g < 2; ++g) {
        const float* src = g ? p.lru_wx : p.lru_wa;
        for (int ld = 0; ld < 4; ++ld)
            p0_transpose(src + (size_t)ld * 4 * 4096, (bf16*)(p.ws + WS_LRUW) + ((size_t)(ld * 2 + g) * 4) * 4096, 64, 64, 4, lds);
    }
    p0_convert(p.peer_keys, (bf16*)(p.ws + WS_KEYS), (size_t)2 * 2 * 128 * 128);
    p0_convert_fp8(p.peer_u, p.ws + WS_U, (float*)(p.ws + WS_US), 2 * NE);
    p0_convert_fp8(p.peer_v, p.ws + WS_V, (float*)(p.ws + WS_VS), 2 * NE);
    if (blockIdx.x == gridDim.x - 1) {
        float2* rt = (float2*)(p.ws + WS_ROPE);
        for (int i = threadIdx.x; i < 128 * 16; i += 256) {
            int pos = i >> 4, f = i & 15;
            float inv = powf(10000.f, -(float)f / 16.f);
            float ang = (float)pos * inv;
            rt[i] = make_float2(cosf(ang), sinf(ang));
        }
    }
}

__device__ __forceinline__ void modnorm_store(const float (&v)[16], const float* g, const float* sc, const float* sh, bf16* hrow, int lane) {
    float ss = 0;
#pragma unroll
    for (int i = 0; i < 16; ++i) ss += v[i] * v[i];
    ss = wave_sum(ss);
    float rstd = rsqrtf(ss * (1.f / 1024.f) + EPS);
#pragma unroll
    for (int hh = 0; hh < 2; ++hh) {
        int e0 = hh * 512 + lane * 8;
        float o[8];
#pragma unroll
        for (int i = 0; i < 8; ++i) o[i] = v[hh * 8 + i] * rstd * g[e0 + i] * (1.f + sc[e0 + i]) + sh[e0 + i];
        uint4 w; w.x = pk2(o[0], o[1]); w.y = pk2(o[2], o[3]); w.z = pk2(o[4], o[5]); w.w = pk2(o[6], o[7]);
        *(uint4*)(hrow + e0) = w;
    }
}
__device__ __forceinline__ void load_row16(const float* row, float (&v)[16], int lane) {
    float4 a = *(const float4*)(row + lane * 8), b = *(const float4*)(row + lane * 8 + 4);
    float4 c = *(const float4*)(row + 512 + lane * 8), d = *(const float4*)(row + 512 + lane * 8 + 4);
    v[0] = a.x; v[1] = a.y; v[2] = a.z; v[3] = a.w; v[4] = b.x; v[5] = b.y; v[6] = b.z; v[7] = b.w;
    v[8] = c.x; v[9] = c.y; v[10] = c.z; v[11] = c.w; v[12] = d.x; v[13] = d.y; v[14] = d.z; v[15] = d.w;
}
__device__ __forceinline__ void phase_rownorm(const Params& p, int l, int which) {
    const int tidx = tid_op(), lane = tidx & 63, gw = blockIdx.x * 4 + __builtin_amdgcn_readfirstlane(tidx >> 6), nw = gridDim.x * 4;
    const float* modv = (const float*)(p.ws + WS_MOD);
    bf16* H = (bf16*)(p.ws + WS_H);
    const int rpw = (M + nw - 1) / nw;
    const float* g = (which ? p.norm_ffn : p.norm_mix) + l * D;
    int cur_mi = -1;
    float gs[16], shv[16];
    for (int r = gw * rpw; r < (gw + 1) * rpw && r < M; ++r) {
        const int mi = mod_idx(r);
        if (l == 1 && which == 1 && mi == 4) continue;
        if (mi != cur_mi) {
            cur_mi = mi;
            const float* mv = modv + ((size_t)l * 5 + mi) * 6144;
            const float* sc = mv + (which ? 4096 : 1024); const float* sh = mv + (which ? 3072 : 0);
#pragma unroll
            for (int hh = 0; hh < 2; ++hh)
#pragma unroll
                for (int i = 0; i < 8; ++i) { const int e0 = hh * 512 + lane * 8 + i; gs[hh * 8 + i] = g[e0] * (1.f + sc[e0]); shv[hh * 8 + i] = sh[e0]; }
        }
        float v[16];
        load_row16(which ? xs_row(p, r) : in_row(p, r), v, lane);
        float ss = 0.f;
#pragma unroll
        for (int i = 0; i < 16; ++i) ss += v[i] * v[i];
        ss = wave_sum(ss);
        const float rstd = rsqrtf(ss * (1.f / 1024.f) + EPS);
        bf16* hrow = H + (size_t)r * D;
#pragma unroll
        for (int hh = 0; hh < 2; ++hh) {
            u4v w;
#pragma unroll
            for (int i = 0; i < 4; ++i) w[i] = pk2(v[hh * 8 + 2 * i] * rstd * gs[hh * 8 + 2 * i] + shv[hh * 8 + 2 * i], v[hh * 8 + 2 * i + 1] * rstd * gs[hh * 8 + 2 * i + 1] + shv[hh * 8 + 2 * i + 1]);
            *(u4v*)(hrow + hh * 512 + lane * 8) = w;
        }
    }
}

typedef short s8v __attribute__((ext_vector_type(8)));
typedef float f4v __attribute__((ext_vector_type(4)));
#define MFMA16(a, b, c) __builtin_amdgcn_mfma_f32_16x16x32_bf16((a), (b), (c), 0, 0, 0)
constexpr int GP = 72;
constexpr int TLDS = 128 * GP;
constexpr int SMEM_BYTES = 4 * TLDS * 2;

template <bool SWAP>
__device__ __forceinline__ void gemm_mainloop(const bf16* __restrict__ A, const bf16* __restrict__ Bt, bf16* lds, f4v (&acc)[4][4]) {
    const int tid = tid_op(), lane = tid & 63, wave = tid >> 6, wm = wave >> 1, wn = wave & 1;
    const int lrow = tid >> 3, lkc = tid & 7;
    const bf16* ag = A + (size_t)lrow * D + lkc * 8;
    const bf16* bg = Bt + (size_t)lrow * D + lkc * 8;
    bf16* sa = lds + lrow * GP + lkc * 8;
    u4v ra[4], rb[4];
#pragma unroll
    for (int i = 0; i < 4; ++i) { ra[i] = *(const u4v*)(ag + (size_t)i * 32 * D); rb[i] = *(const u4v*)(bg + (size_t)i * 32 * D); }
#pragma unroll
    for (int i = 0; i < 4; ++i) { *(u4v*)(sa + i * 32 * GP) = ra[i]; *(u4v*)(sa + TLDS + i * 32 * GP) = rb[i]; }
    __syncthreads();
    const int fro = (lane & 15) * GP + (lane >> 4) * 8;
#pragma unroll 1
    for (int kt = 0; kt < 16; ++kt) {
        const int buf = kt & 1;
        if (kt + 1 < 16) {
#pragma unroll
            for (int i = 0; i < 4; ++i) { ra[i] = *(const u4v*)(ag + (size_t)i * 32 * D + (kt + 1) * 64); rb[i] = *(const u4v*)(bg + (size_t)i * 32 * D + (kt + 1) * 64); }
        }
        const bf16* As = lds + buf * 2 * TLDS + wm * 64 * GP + fro;
        const bf16* Bs = lds + buf * 2 * TLDS + TLDS + wn * 64 * GP + fro;
#pragma unroll
        for (int ks = 0; ks < 2; ++ks) {
            s8v af[4], bfr[4];
#pragma unroll
            for (int i = 0; i < 4; ++i) { af[i] = *(const s8v*)(As + i * 16 * GP + ks * 32); bfr[i] = *(const s8v*)(Bs + i * 16 * GP + ks * 32); }
            __builtin_amdgcn_s_setprio(1);
#pragma unroll
            for (int mi = 0; mi < 4; ++mi)
#pragma unroll
                for (int nj = 0; nj < 4; ++nj)
                    acc[mi][nj] = SWAP ? MFMA16(bfr[nj], af[mi], acc[mi][nj]) : MFMA16(af[mi], bfr[nj], acc[mi][nj]);
            __builtin_amdgcn_s_setprio(0);
        }
        if (kt + 1 < 16) {
            bf16* sd = sa + (buf ^ 1) * 2 * TLDS;
#pragma unroll
            for (int i = 0; i < 4; ++i) { *(u4v*)(sd + i * 32 * GP) = ra[i]; *(u4v*)(sd + TLDS + i * 32 * GP) = rb[i]; }
        }
        __syncthreads();
    }
}

__device__ __forceinline__ void phase_inproj_fast(const Params& p, int l, bf16* lds) {
    const int tid = tid_op(), lane = tid & 63, wave = tid >> 6, wm = wave >> 1, wn = wave & 1, l15 = lane & 15, gq = lane >> 4;
    const bf16* H = (const bf16*)(p.ws + WS_H);
    const bf16* W = (const bf16*)(p.ws + WS_WIN) + (size_t)l * DIN * D;
    bf16* Z = (bf16*)(p.ws + WS_Z);
    const float2* rt = (const float2*)(p.ws + WS_ROPE);
    for (int tile = blockIdx.x; tile < 264 * 18; tile += gridDim.x) {
        const int mt = tile / 18, nt = tile - mt * 18;
        const bf16* A = H + (size_t)mt * 128 * D;
        const bf16* Bt = W + (size_t)nt * 128 * D;
        const int bb = mt / 66, jt = (mt - bb * 66) * 128;
        f4v acc[4][4];
#pragma unroll
        for (int i = 0; i < 4; ++i)
#pragma unroll
            for (int j = 0; j < 4; ++j) acc[i][j] = (f4v){0.f, 0.f, 0.f, 0.f};
        const int s = nt * 2 + wn;
        const bool isv = (nt == 3) || (nt == 7) || (nt == 12) || (nt == 13);
        if (isv) {
            gemm_mainloop<false>(A, Bt, lds, acc);
            int vkind, vh;
            if (s < 8) { vkind = 0; vh = s - 6; } else if (s < 16) { vkind = 1; vh = s - 14; } else { vkind = 2; vh = s - 24; }
            bf16* vt = (vkind == 0) ? (bf16*)(p.ws + WS_VTA) + ((size_t)(bb * 2 + vh) * 64) * TB
                     : (vkind == 1) ? (bf16*)(p.ws + WS_VTB) + ((size_t)(bb * 2 + vh) * 64) * TB
                                    : (bf16*)(p.ws + WS_VTN) + ((size_t)(bb * 4 + vh) * 64) * TB;
            bf16* stg = lds + wave * (64 * GP);
#pragma unroll
            for (int mi = 0; mi < 4; ++mi)
#pragma unroll
                for (int nj = 0; nj < 4; ++nj) {
                    uint2 w; w.x = pk2(acc[mi][nj][0], acc[mi][nj][1]); w.y = pk2(acc[mi][nj][2], acc[mi][nj][3]);
                    *(uint2*)(stg + (nj * 16 + l15) * GP + mi * 16 + gq * 4) = w;
                }
#pragma unroll
            for (int it = 0; it < 8; ++it) {
                const int rs = it * 8 + (lane >> 3), ch = lane & 7;
                *(u4v*)(vt + (size_t)rs * TB + jt + wm * 64 + ch * 8) = *(const u4v*)(stg + rs * GP + ch * 8);
            }
        } else {
            gemm_mainloop<true>(A, Bt, lds, acc);
            int zcol; bool nrm = false, rope = false, isq = false; const float* g = p.qn_g;
            if (s < 4) { zcol = ZQA + 64 * s; rope = true; isq = true; }
            else if (s < 6) { zcol = ZKA + 64 * (s - 4); rope = true; }
            else if (s < 12) { zcol = ZQB + 64 * (s - 8); rope = true; isq = true; nrm = true; g = p.qn_g + l * 64; }
            else if (s < 14) { zcol = ZKB + 64 * (s - 12); rope = true; nrm = true; g = p.kn_g + l * 64; }
            else if (s < 20) { zcol = ZQN + 64 * (s - 16); isq = true; }
            else if (s < 24) { zcol = ZKN + 64 * (s - 20); }
            else if (s < 32) { zcol = ZXR + 64 * (s - 28); }
            else { zcol = ZXG + 64 * (s - 32); }
            const bool latent = jt >= LC;
            bf16* stg = lds + wave * (64 * GP);
#pragma unroll
            for (int mi = 0; mi < 4; ++mi) {
                const int j = jt + wm * 64 + mi * 16 + l15;
                float v[4][4];
#pragma unroll
                for (int nj = 0; nj < 4; ++nj)
#pragma unroll
                    for (int q = 0; q < 4; ++q) v[nj][q] = acc[mi][nj][q];
                if (nrm) {
                    float ss = 0.f;
#pragma unroll
                    for (int nj = 0; nj < 4; ++nj)
#pragma unroll
                        for (int q = 0; q < 4; ++q) ss += v[nj][q] * v[nj][q];
                    ss += __shfl_xor(ss, 16); ss += __shfl_xor(ss, 32);
                    const float rstd = rsqrtf(ss * (1.f / 64.f) + EPS);
#pragma unroll
                    for (int nj = 0; nj < 4; ++nj) {
                        const float4 g4 = *(const float4*)(g + nj * 16 + gq * 4);
                        v[nj][0] *= rstd * g4.x; v[nj][1] *= rstd * g4.y; v[nj][2] *= rstd * g4.z; v[nj][3] *= rstd * g4.w;
                    }
                }
                if (rope && latent) {
                    const int t = j - LC, pr = t >> 6, pc = t & 63;
                    const float4* r1 = (const float4*)(rt + pr * 16 + gq * 4);
                    const float4* r2 = (const float4*)(rt + pc * 16 + gq * 4);
                    const float4 a0 = r1[0], a1 = r1[1], b0 = r2[0], b1 = r2[1];
                    const float cs1[4][2] = {{a0.x, a0.y}, {a0.z, a0.w}, {a1.x, a1.y}, {a1.z, a1.w}};
                    const float cs2[4][2] = {{b0.x, b0.y}, {b0.z, b0.w}, {b1.x, b1.y}, {b1.z, b1.w}};
#pragma unroll
                    for (int q = 0; q < 4; ++q) {
                        const float x1 = v[0][q], x2 = v[1][q], y1 = v[2][q], y2 = v[3][q];
                        v[0][q] = x1 * cs1[q][0] - x2 * cs1[q][1]; v[1][q] = x1 * cs1[q][1] + x2 * cs1[q][0];
                        v[2][q] = y1 * cs2[q][0] - y2 * cs2[q][1]; v[3][q] = y1 * cs2[q][1] + y2 * cs2[q][0];
                    }
                }
                const float sc = isq ? (nrm ? 0.125f * 1.4426950408889634f : 0.125f) : 1.f;
#pragma unroll
                for (int nj = 0; nj < 4; ++nj) {
                    uint2 w; w.x = pk2(v[nj][0] * sc, v[nj][1] * sc); w.y = pk2(v[nj][2] * sc, v[nj][3] * sc);
                    *(uint2*)(stg + (mi * 16 + l15) * GP + nj * 16 + gq * 4) = w;
                }
            }
            {
                const size_t r0 = (size_t)bb * TB + jt + wm * 64;
#pragma unroll
                for (int it = 0; it < 8; ++it) {
                    const int rs = it * 8 + (lane >> 3), ch = lane & 7;
                    *(u4v*)(Z + (r0 + rs) * ZP + zcol + ch * 8) = *(const u4v*)(stg + rs * GP + ch * 8);
                }
            }
        }
        __syncthreads();
    }
}

__device__ __forceinline__ void phase_outproj_fast(const Params& p, int l, bf16* lds) {
    const int tid = tid_op(), lane = tid & 63, wave = tid >> 6, wm = wave >> 1, wn = wave & 1, l15 = lane & 15, gq = lane >> 4;
    const bf16* Y = (const bf16*)(p.ws + WS_Y);
    const bf16* W = (const bf16*)(p.ws + WS_WOUT) + (size_t)l * D * D;
    const float* modv = (const float*)(p.ws + WS_MOD);
    for (int tile = blockIdx.x; tile < 264 * 8; tile += gridDim.x) {
        const int mt = tile >> 3, nt = tile & 7;
        const int bb = mt / 66, jt = (mt - bb * 66) * 128;
        if (l == 1 && jt < LC) continue;
        f4v acc[4][4];
#pragma unroll
        for (int i = 0; i < 4; ++i)
#pragma unroll
            for (int j = 0; j < 4; ++j) acc[i][j] = (f4v){0.f, 0.f, 0.f, 0.f};
        gemm_mainloop<true>(Y + (size_t)mt * 128 * D, W + (size_t)nt * 128 * D, lds, acc);
        const float* gtv = modv + ((size_t)l * 5 + (jt < LC ? 4 : bb)) * 6144 + 2048;
#pragma unroll
        for (int mi = 0; mi < 4; ++mi) {
            const int r = bb * TB + jt + wm * 64 + mi * 16 + l15;
            const float* xin = (l == 0) ? in_row(p, r) : xs_row(p, r);
            float* xo = xs_row(p, r);
#pragma unroll
            for (int nj = 0; nj < 4; ++nj) {
                const int col = nt * 128 + wn * 64 + nj * 16 + gq * 4;
                const float4 xi = *(const float4*)(xin + col), gt = *(const float4*)(gtv + col);
                *(float4*)(xo + col) = make_float4(xi.x + gt.x * acc[mi][nj][0], xi.y + gt.y * acc[mi][nj][1], xi.z + gt.z * acc[mi][nj][2], xi.w + gt.w * acc[mi][nj][3]);
            }
        }
    }
}


__device__ __forceinline__ void ce_desc(unsigned& a, unsigned& b) { const unsigned hi = max(a, b), lo = min(a, b); a = hi; b = lo; }
__device__ __forceinline__ void bitonic_merge16(unsigned (&v)[16]) {
#pragma unroll
    for (int j = 8; j > 0; j >>= 1)
#pragma unroll
        for (int i = 0; i < 16; ++i) { const int l = i ^ j; if (l > i) ce_desc(v[i], v[l]); }
}
__device__ __forceinline__ void bitonic_sort16(unsigned (&v)[16]) {
#pragma unroll
    for (int k = 2; k <= 16; k <<= 1)
#pragma unroll
        for (int j = k >> 1; j > 0; j >>= 1)
#pragma unroll
            for (int i = 0; i < 16; ++i) {
                const int l = i ^ j;
                if (l > i) { if ((i & k) == 0 || k == 16) ce_desc(v[i], v[l]); else ce_desc(v[l], v[i]); }
            }
}
__device__ __forceinline__ unsigned f2ord(float f) { unsigned u = __float_as_uint(f); return (u & 0x80000000u) ? ~u : (u | 0x80000000u); }
__device__ __forceinline__ void phase_peerq_fast(const Params& p, int l, bf16* lds) {
    const int tid = tid_op(), lane = tid & 63, wave = tid >> 6, wm = wave >> 1, wn = wave & 1, l15 = lane & 15, gq = lane >> 4;
    const bf16* H = (const bf16*)(p.ws + WS_H);
    const bf16* W = (const bf16*)(p.ws + WS_WQ) + (size_t)l * 2048 * D;
    const bf16* KY = (const bf16*)(p.ws + WS_KEYS) + (size_t)l * 2 * 128 * 128;
    float* stop = (float*)(p.ws + WS_STOP);
    unsigned char* itop = p.ws + WS_ITOP;
    constexpr int QP = 136, SP = 132;
    bf16* Qs = lds; bf16* Ks = lds + 128 * QP;
    float* Sf = (float*)lds;
    for (int tile = blockIdx.x; tile < 264 * 16; tile += gridDim.x) {
        const int mt = tile >> 4, hp = tile & 15;
        const int bb = mt / 66, jt = (mt - bb * 66) * 128;
        if (l == 1 && jt < LC) continue;
        f4v acc[4][4];
#pragma unroll
        for (int i = 0; i < 4; ++i)
#pragma unroll
            for (int j = 0; j < 4; ++j) acc[i][j] = (f4v){0.f, 0.f, 0.f, 0.f};
        u4v kreg[8];
        {
            const bf16* kg = KY + (size_t)(hp & 1) * 128 * 128;
#pragma unroll
            for (int i = 0; i < 8; ++i) { int c = tid + i * 256, row = c >> 4, kc = c & 15; kreg[i] = *(const u4v*)(kg + row * 128 + kc * 8); }
        }
        gemm_mainloop<true>(H + (size_t)mt * 128 * D, W + (size_t)hp * 128 * D, lds, acc);
#pragma unroll
        for (int mi = 0; mi < 4; ++mi)
#pragma unroll
            for (int nj = 0; nj < 4; ++nj) {
                uint2 w; w.x = pk2(acc[mi][nj][0], acc[mi][nj][1]); w.y = pk2(acc[mi][nj][2], acc[mi][nj][3]);
                *(uint2*)(Qs + (wm * 64 + mi * 16 + l15) * QP + wn * 64 + nj * 16 + gq * 4) = w;
            }
#pragma unroll
        for (int i = 0; i < 8; ++i) { int c = tid + i * 256, row = c >> 4, kc = c & 15; *(u4v*)(Ks + row * QP + kc * 8) = kreg[i]; }
        __syncthreads();
        f4v a2[2][8];
#pragma unroll
        for (int i = 0; i < 2; ++i)
#pragma unroll
            for (int j = 0; j < 8; ++j) a2[i][j] = (f4v){0.f, 0.f, 0.f, 0.f};
#pragma unroll
        for (int ks = 0; ks < 4; ++ks) {
            s8v af[2], bfr[8];
#pragma unroll
            for (int i = 0; i < 2; ++i) af[i] = *(const s8v*)(Qs + (wave * 32 + i * 16 + l15) * QP + ks * 32 + gq * 8);
#pragma unroll
            for (int j = 0; j < 8; ++j) bfr[j] = *(const s8v*)(Ks + (j * 16 + l15) * QP + ks * 32 + gq * 8);
            __builtin_amdgcn_s_setprio(1);
#pragma unroll
            for (int i = 0; i < 2; ++i)
#pragma unroll
                for (int j = 0; j < 8; ++j) a2[i][j] = MFMA16(bfr[j], af[i], a2[i][j]);
            __builtin_amdgcn_s_setprio(0);
        }
        __syncthreads();
#pragma unroll
        for (int i = 0; i < 2; ++i)
#pragma unroll
            for (int j = 0; j < 8; ++j) *(f4v*)(Sf + (wave * 32 + i * 16 + l15) * SP + j * 16 + gq * 4) = a2[i][j];
        __syncthreads();
        {
            const int row = tid >> 1, half = tid & 1;
            const float* sr = Sf + row * SP;
            unsigned L[16];
#pragma unroll
            for (int ch = 0; ch < 4; ++ch) {
                unsigned C[16];
#pragma unroll
                for (int i4 = 0; i4 < 4; ++i4) {
                    const int col = half * 64 + ch * 16 + i4 * 4;
                    const f4v s4 = *(const f4v*)(sr + col);
#pragma unroll
                    for (int q = 0; q < 4; ++q) C[i4 * 4 + q] = (f2ord(s4[q]) & ~127u) | (unsigned)(col + q);
                }
                bitonic_sort16(C);
                if (ch == 0) {
#pragma unroll
                    for (int i = 0; i < 16; ++i) L[i] = C[i];
                } else {
#pragma unroll
                    for (int i = 0; i < 16; ++i) L[i] = max(L[i], C[15 - i]);
                    bitonic_merge16(L);
                }
            }
            {
                unsigned Pn[16];
#pragma unroll
                for (int i = 0; i < 16; ++i) Pn[i] = __shfl_xor(L[i], 1);
#pragma unroll
                for (int i = 0; i < 16; ++i) L[i] = max(L[i], Pn[15 - i]);
                bitonic_merge16(L);
            }
            if (half == 0) {
                const size_t r = (size_t)bb * TB + jt + row;
                float sv[16];
#pragma unroll
                for (int i = 0; i < 16; ++i) sv[i] = sr[L[i] & 127u];
                float* so = stop + (r * 16 + hp) * 16;
#pragma unroll
                for (int i = 0; i < 4; ++i) *(float4*)(so + i * 4) = make_float4(sv[i * 4], sv[i * 4 + 1], sv[i * 4 + 2], sv[i * 4 + 3]);
                u4v iw;
#pragma unroll
                for (int i = 0; i < 4; ++i) iw[i] = (L[i * 4] & 127u) | ((L[i * 4 + 1] & 127u) << 8) | ((L[i * 4 + 2] & 127u) << 16) | ((L[i * 4 + 3] & 127u) << 24);
                *(u4v*)(itop + (r * 16 + hp) * 16) = iw;
            }
        }
        __syncthreads();
    }
}


__device__ __forceinline__ unsigned cvtpk(float lo, float hi) { f32x2_t v = {lo, hi}; return __builtin_bit_cast(unsigned, __builtin_convertvector(v, bf16x2_t)); }
__device__ __forceinline__ float max3f(float a, float b, float c) { float r; asm("v_max3_f32 %0, %1, %2, %3" : "=v"(r) : "v"(a), "v"(b), "v"(c)); return r; }
constexpr int ATL = 64 * GP;
constexpr int BIAS_OFF_B = 66048, LRUW_OFF_B = 49152;

template <int KIND>
__device__ __forceinline__ void attn_item_fast(const Params& p, int l, int b, int hsel, int blk, bool ctxq, bf16* lds, const float* biasLds) {
    constexpr int kind = KIND;
    const int tid = tid_op(), lane = tid & 63, wave = __builtin_amdgcn_readfirstlane(tid >> 6), l15 = lane & 15, gq = lane >> 4;
    const bf16* Z = (const bf16*)(p.ws + WS_Z) + (size_t)b * TB * ZP;
    int head, j0;
    if (kind == 2) { head = hsel; j0 = ctxq ? wave * 64 : LC + (blk * 4 + wave) * 64; }
    else { head = hsel * 2 + (wave >> 1); j0 = (ctxq ? 0 : LC) + blk * 128 + (wave & 1) * 64; }
    const int kvh = (kind == 2) ? head : hsel;
    const int qcol = (kind == 0 ? ZQA : kind == 1 ? ZQB : ZQN) + head * 64;
    const int kcol = (kind == 0 ? ZKA : kind == 1 ? ZKB : ZKN) + kvh * 64;
    const bf16* Vg = (kind == 0) ? (const bf16*)(p.ws + WS_VTA) + ((size_t)(b * 2 + kvh) * 64) * TB
                   : (kind == 1) ? (const bf16*)(p.ws + WS_VTB) + ((size_t)(b * 2 + kvh) * 64) * TB
                                 : (const bf16*)(p.ws + WS_VTN) + ((size_t)(b * 4 + kvh) * 64) * TB;
    const bf16* Kg = Z + kcol;
    s8v qf[4][2];
#pragma unroll
    for (int nt = 0; nt < 4; ++nt)
#pragma unroll
        for (int ks = 0; ks < 2; ++ks) qf[nt][ks] = *(const s8v*)(Z + (size_t)(j0 + nt * 16 + l15) * ZP + qcol + ks * 32 + gq * 8);
#pragma unroll
    for (int nt = 0; nt < 4; ++nt)
#pragma unroll
        for (int ks = 0; ks < 2; ++ks) asm volatile("" : "+v"(qf[nt][ks]));
    int ntile = 4, locbase = 0;
    if (!ctxq) {
        if (kind == 1) { ntile = 132; }
        else if (kind == 0) { int lo = (blk - 1) * 128, hi = (blk + 2) * 128; lo = lo < 0 ? 0 : lo; hi = hi > SEQ ? SEQ : hi; ntile = 4 + ((hi - lo) >> 6); locbase = LC + lo; }
        else { int lo = blk * 4 - 4; lo = lo < 0 ? 0 : (lo > 120 ? 120 : lo); int hi = blk * 4 + 3 - 4; hi = hi < 0 ? 0 : (hi > 120 ? 120 : hi); hi += 7; ntile = 4 + (hi - lo + 1); locbase = LC + lo * 64; }
    }
    const int qt0 = j0 - LC;
    int kr0w = (qt0 >> 6) - 4; kr0w = kr0w < 0 ? 0 : (kr0w > 120 ? 120 : kr0w);
    f4v ot[4][4];
    float mrun[4], ls[4];
#pragma unroll
    for (int i = 0; i < 4; ++i) {
        mrun[i] = -1e30f; ls[i] = 0.f;
#pragma unroll
        for (int j = 0; j < 4; ++j) ot[i][j] = (f4v){0.f, 0.f, 0.f, 0.f};
    }
    float negc = 0.f;
    if (KIND == 1) {
        const float gqm = wave_max(fabsf(p.qn_g[l * 64 + lane])), gkm = wave_max(fabsf(p.kn_g[l * 64 + lane]));
        negc = -8.f * gqm * gkm * 1.0002f * 1.4426950408889634f;
    }
    const int lr = tid >> 3, lc = tid & 7;
    const int vpos = (lc >> 2) * 32 + (lc & 1) * 16 + ((lc >> 1) & 1) * 4;
    u4v rk[2], rv[2];
    {
        const int kb0 = 0;
#pragma unroll
        for (int c = 0; c < 2; ++c) {
            rk[c] = *(const u4v*)(Kg + (size_t)(kb0 + lr + 32 * c) * ZP + lc * 8);
            rv[c] = *(const u4v*)(Vg + (size_t)(lr + 32 * c) * TB + kb0 + lc * 8);
        }
#pragma unroll
        for (int c = 0; c < 2; ++c) {
            *(u4v*)(lds + (lr + 32 * c) * GP + lc * 8) = rk[c];
            bf16* vd = lds + ATL + (lr + 32 * c) * GP + vpos;
            *(uint2*)vd = make_uint2(rv[c][0], rv[c][1]); *(uint2*)(vd + 8) = make_uint2(rv[c][2], rv[c][3]);
        }
    }
    __syncthreads();
#pragma unroll 1
    for (int i = 0; i < ntile; ++i) {
        const int buf = i & 1;
        if (i + 1 < ntile) {
            const int kb1 = (kind == 1 || ctxq || i + 1 < 4) ? (i + 1) * 64 : locbase + (i + 1 - 4) * 64;
#pragma unroll
            for (int c = 0; c < 2; ++c) {
                rk[c] = *(const u4v*)(Kg + (size_t)(kb1 + lr + 32 * c) * ZP + lc * 8);
                rv[c] = *(const u4v*)(Vg + (size_t)(lr + 32 * c) * TB + kb1 + lc * 8);
            }
        }
        bool use = true; int maskmode = 0; int tt0 = 0, krow = 0;
        if (!ctxq && i >= 4) {
            if (kind == 0) { tt0 = locbase - LC + (i - 4) * 64; use = (tt0 + 63 >= qt0 - 128) && (tt0 <= qt0 + 63 + 128); maskmode = 1; }
            else if (kind == 2) { krow = ((locbase - LC) >> 6) + (i - 4); use = (krow >= kr0w) && (krow < kr0w + 8); maskmode = 2; }
        }
        if (use) {
            const bf16* Ks = lds + buf * 2 * ATL;
            const bf16* Vs = Ks + ATL;
            const float* bt = biasLds + head * 465 + (krow - (qt0 >> 6) + 7) * 31 + 15;
#pragma unroll 1
            for (int hk = 0; hk < 2; ++hk) {
                f4v st[2][4];
#pragma unroll
                for (int a = 0; a < 2; ++a)
#pragma unroll
                    for (int c = 0; c < 4; ++c) st[a][c] = (f4v){negc, negc, negc, negc};
#pragma unroll
                for (int ks = 0; ks < 2; ++ks) {
                    s8v kf[2];
#pragma unroll
                    for (int mt = 0; mt < 2; ++mt) kf[mt] = *(const s8v*)(Ks + ((hk * 2 + mt) * 16 + l15) * GP + ks * 32 + gq * 8);
                    __builtin_amdgcn_s_setprio(1);
#pragma unroll
                    for (int mt = 0; mt < 2; ++mt)
#pragma unroll
                        for (int nt = 0; nt < 4; ++nt) st[mt][nt] = MFMA16(kf[mt], qf[nt][ks], st[mt][nt]);
                    __builtin_amdgcn_s_setprio(0);
                }
                if (maskmode == 1) {
#pragma unroll
                    for (int nt = 0; nt < 4; ++nt) {
                        const int qt = qt0 + nt * 16 + l15;
#pragma unroll
                        for (int mt = 0; mt < 2; ++mt)
#pragma unroll
                            for (int q = 0; q < 4; ++q) { int dl = tt0 + (hk * 2 + mt) * 16 + gq * 4 + q - qt; if (dl > 128 || dl < -128) st[mt][nt][q] = -1e30f; }
                    }
                } else if (maskmode == 2) {
#pragma unroll
                    for (int nt = 0; nt < 4; ++nt) {
                        const int qc = nt * 16 + l15;
                        int cs0 = qc - 8; cs0 = cs0 < 0 ? 0 : (cs0 > 48 ? 48 : cs0);
#pragma unroll
                        for (int mt = 0; mt < 2; ++mt)
#pragma unroll
                            for (int q = 0; q < 4; ++q) {
                                const int kc = (hk * 2 + mt) * 16 + gq * 4 + q;
                                int dc = kc - qc; dc = dc < -15 ? -15 : (dc > 15 ? 15 : dc);
                                const bool ok = (kc >= cs0) && (kc < cs0 + 16);
                                st[mt][nt][q] = ok ? st[mt][nt][q] + bt[dc] : -1e30f;
                            }
                    }
                }
                s8v pf[4];
#pragma unroll
                for (int nt = 0; nt < 4; ++nt) {
                    float psum = 0.f;
                    if (KIND == 1) {
#pragma unroll
                        for (int mt = 0; mt < 2; ++mt)
#pragma unroll
                            for (int q = 0; q < 4; ++q) { float pv = __builtin_amdgcn_exp2f(st[mt][nt][q]); st[mt][nt][q] = pv; psum += pv; }
                    } else {
                        float mx = max3f(max3f(st[0][nt][0], st[0][nt][1], st[0][nt][2]), max3f(st[0][nt][3], st[1][nt][0], st[1][nt][1]), max3f(st[1][nt][2], st[1][nt][3], mrun[nt]));
                        if (__any(mx > mrun[nt] + 8.f)) {
                            mx = max3f(mx, __shfl_xor(mx, 16), mx); mx = max3f(mx, __shfl_xor(mx, 32), mx);
                            const float mnew = fmaxf(mrun[nt], mx);
                            const float alpha = __expf(mrun[nt] - mnew);
                            mrun[nt] = mnew;
                            ls[nt] *= alpha;
#pragma unroll
                            for (int dt = 0; dt < 4; ++dt) ot[dt][nt] *= alpha;
                        }
                        const float mcur = mrun[nt];
#pragma unroll
                        for (int mt = 0; mt < 2; ++mt)
#pragma unroll
                            for (int q = 0; q < 4; ++q) { float pv = __expf(st[mt][nt][q] - mcur); st[mt][nt][q] = pv; psum += pv; }
                    }
                    ls[nt] += psum;
                    u4v w;
                    w[0] = cvtpk(st[0][nt][0], st[0][nt][1]); w[1] = cvtpk(st[0][nt][2], st[0][nt][3]);
                    w[2] = cvtpk(st[1][nt][0], st[1][nt][1]); w[3] = cvtpk(st[1][nt][2], st[1][nt][3]);
                    pf[nt] = __builtin_bit_cast(s8v, w);
                }
                s8v vf[4];
#pragma unroll
                for (int dt = 0; dt < 4; ++dt) {
                    vf[dt] = *(const s8v*)(Vs + (dt * 16 + l15) * GP + hk * 32 + gq * 8);
                }
                __builtin_amdgcn_s_setprio(1);
#pragma unroll
                for (int dt = 0; dt < 4; ++dt)
#pragma unroll
                    for (int nt = 0; nt < 4; ++nt) ot[dt][nt] = MFMA16(vf[dt], pf[nt], ot[dt][nt]);
                __builtin_amdgcn_s_setprio(0);
            }
        }
        if (i + 1 < ntile) {
            bf16* kd = lds + (buf ^ 1) * 2 * ATL;
#pragma unroll
            for (int c = 0; c < 2; ++c) {
                *(u4v*)(kd + (lr + 32 * c) * GP + lc * 8) = rk[c];
                bf16* vd = kd + ATL + (lr + 32 * c) * GP + vpos;
                *(uint2*)vd = make_uint2(rv[c][0], rv[c][1]); *(uint2*)(vd + 8) = make_uint2(rv[c][2], rv[c][3]);
            }
        }
        __syncthreads();
    }
    const float sk = (kind == 0) ? p.attn_sink[l * 4 + head] : 0.f;
#pragma unroll
    for (int nt = 0; nt < 4; ++nt) {
        float lsum = ls[nt];
        lsum += __shfl_xor(lsum, 16); lsum += __shfl_xor(lsum, 32);
        float scale = 1.f;
        if (kind == 0) { const float mx = fmaxf(mrun[nt], sk), a = __expf(mrun[nt] - mx); lsum = lsum * a + __expf(sk - mx); scale = a; }
        const float inv = scale / lsum;
        bf16* y = (bf16*)(p.ws + WS_Y) + ((size_t)b * TB + j0 + nt * 16 + l15) * D + kind * 256 + head * 64;
#pragma unroll
        for (int dt = 0; dt < 4; ++dt) {
            uint2 w; w.x = cvtpk(ot[dt][nt][0] * inv, ot[dt][nt][1] * inv); w.y = cvtpk(ot[dt][nt][2] * inv, ot[dt][nt][3] * inv);
            *(uint2*)(y + dt * 16 + gq * 4) = w;
        }
    }
}


constexpr int LX_OFF = 0, LU_OFF = 8704, LA_OFF = 17920, LB_OFF = 34304, LCW_OFF = 50688, LWX_OFF = 51968;
template <int STP>
__device__ __forceinline__ void seg_aggr(const float* Aa, const float* Bb, int a0, float& ap, float& hl) {
#pragma unroll
    for (int half = 0; half < 2; ++half) {
        float av[8], bv[8];
#pragma unroll
        for (int i = 0; i < 8; ++i) { av[i] = Aa[a0 + (half * 8 + i) * STP]; bv[i] = Bb[a0 + (half * 8 + i) * STP]; }
#pragma unroll
        for (int i = 0; i < 8; ++i) { hl = av[i] * hl + bv[i]; ap *= av[i]; }
    }
}
template <int STP>
__device__ __forceinline__ void seg_apply(float* Aa, float* Bb, int a0, float hin, float ain) {
#pragma unroll
    for (int half = 0; half < 2; ++half) {
        float av[8], bv[8];
#pragma unroll
        for (int i = 0; i < 8; ++i) { av[i] = Aa[a0 + (half * 8 + i) * STP]; bv[i] = Bb[a0 + (half * 8 + i) * STP]; }
#pragma unroll
        for (int i = 0; i < 8; ++i) { hin = av[i] * hin + bv[i]; ain *= av[i]; av[i] = hin; bv[i] = ain; }
#pragma unroll
        for (int i = 0; i < 8; ++i) { Aa[a0 + (half * 8 + i) * STP] = av[i]; Bb[a0 + (half * 8 + i) * STP] = bv[i]; }
    }
}
constexpr int LRU_NSEG = 6, LRU_SEGC = 22;
constexpr int LRU_ITEMS = 16 * 2 * LRU_NSEG;
__device__ __forceinline__ void lru_item_fast(const Params& p, int l, int b, int n, int dir, int seg, unsigned char* smem) {
    const int tid = tid_op(), lane = tid & 63, wave = __builtin_amdgcn_readfirstlane(tid >> 6), l15 = lane & 15, gq = lane >> 4;
    bf16* Xs = (bf16*)(smem + LX_OFF);
    bf16* Us = (bf16*)(smem + LU_OFF);
    float* Aa = (float*)(smem + LA_OFF);
    float* Bb = (float*)(smem + LB_OFF);
    float* CW = (float*)(smem + LCW_OFF);
    float* SAg = (float*)(smem + LWX_OFF + 9216);
    float* SBg = SAg + 256;
    bf16* WXs = (bf16*)(smem + LWX_OFF);
    const bf16* Z = (const bf16*)(p.ws + WS_Z) + (size_t)b * TB * ZP;
    float* HL = (float*)(p.ws + (dir ? WS_H : WS_HF)) + ((size_t)b * TB) * 256 + n * 64;
    float* AC = HL + (size_t)M * 256;
    for (int i = tid; i < 320; i += 256) { int q = i >> 6, c = i & 63; CW[i] = (q < 4) ? p.conv_w[(l * 4 + q) * 256 + n * 64 + c] : p.conv_b[l * 256 + n * 64 + c]; }
    const int ptok = tid >> 2, ppart = tid & 3;
    const int lr = tid >> 3, lc = tid & 7;
    const bf16* wbase = (const bf16*)(p.ws + WS_LRUW) + ((size_t)((l * 2 + dir) * 2) * 4 + n) * 4096;
    s8v wfa[4][2];
#pragma unroll
    for (int nj = 0; nj < 4; ++nj)
#pragma unroll
        for (int ks = 0; ks < 2; ++ks) wfa[nj][ks] = *(const s8v*)(wbase + (nj * 16 + l15) * 64 + ks * 32 + gq * 8);
#pragma unroll
    for (int i = 0; i < 2; ++i) { int cidx = tid + i * 256, row = cidx >> 3, kc = cidx & 7; *(u4v*)(WXs + row * GP + kc * 8) = *(const u4v*)(wbase + (size_t)4 * 4096 + row * 64 + kc * 8); }
    float cba[4], cbx[4], csp[4];
#pragma unroll
    for (int nj = 0; nj < 4; ++nj) {
        const int ch = n * 64 + nj * 16 + l15;
        cba[nj] = p.lru_ba[(l * 2 + dir) * 256 + ch]; cbx[nj] = p.lru_bx[(l * 2 + dir) * 256 + ch];
        const float lam = p.lru_lam[(l * 2 + dir) * 256 + ch];
        csp[nj] = (lam > 15.f) ? __expf(-lam) : log1pf(__expf(-lam));
    }
#pragma unroll
    for (int nj = 0; nj < 4; ++nj) {
#pragma unroll
        for (int ks = 0; ks < 2; ++ks) asm volatile("" : "+v"(wfa[nj][ks]));
        asm volatile("" : "+v"(cba[nj]), "+v"(cbx[nj]), "+v"(csp[nj]));
    }
    float h = 0.f, ain = 1.f;
    u4v rx[3];
    const int cbeg = seg * LRU_SEGC;
    {
        const int c = cbeg;
        const int jlo = dir ? (c < 4 ? LC - 64 - c * 64 : TB + LC - 64 - c * 64) : c * 64;
        const int lo = (jlo < LC) ? 0 : LC, hi = (jlo < LC) ? LC : TB;
#pragma unroll
        for (int i = 0; i < 3; ++i) { int row = lr + 32 * i, jj = jlo - 2 + row; rx[i] = (row < 67 && jj >= lo && jj < hi) ? *(const u4v*)(Z + (size_t)jj * ZP + ZXR + n * 64 + lc * 8) : (u4v){0u, 0u, 0u, 0u}; }
#pragma unroll
        for (int i = 0; i < 3; ++i) if (lr + 32 * i < 68) *(u4v*)(Xs + (lr + 32 * i) * 64 + lc * 8) = rx[i];
    }
#pragma unroll 1
    for (int c = cbeg; c < cbeg + LRU_SEGC; ++c) {
        const int jlo = dir ? (c < 4 ? LC - 64 - c * 64 : TB + LC - 64 - c * 64) : c * 64;
        if (c + 1 < cbeg + LRU_SEGC) {
            const int c1 = c + 1;
            const int jn = dir ? (c1 < 4 ? LC - 64 - c1 * 64 : TB + LC - 64 - c1 * 64) : c1 * 64;
            const int lo = (jn < LC) ? 0 : LC, hi = (jn < LC) ? LC : TB;
#pragma unroll
            for (int i = 0; i < 3; ++i) { int row = lr + 32 * i, jj = jn - 2 + row; rx[i] = (row < 67 && jj >= lo && jj < hi) ? *(const u4v*)(Z + (size_t)jj * ZP + ZXR + n * 64 + lc * 8) : (u4v){0u, 0u, 0u, 0u}; }
        }
        lds_barrier();
        {
            float u[16];
#pragma unroll
            for (int i = 0; i < 16; ++i) u[i] = CW[256 + ppart * 16 + i];
#pragma unroll
            for (int q = 0; q < 4; ++q) {
                const u4v x0 = *(const u4v*)(Xs + (ptok + q) * 64 + ppart * 16), x1 = *(const u4v*)(Xs + (ptok + q) * 64 + ppart * 16 + 8);
#pragma unroll
                for (int i = 0; i < 4; ++i) {
                    u[2 * i] += CW[q * 64 + ppart * 16 + 2 * i] * lo16(x0[i]); u[2 * i + 1] += CW[q * 64 + ppart * 16 + 2 * i + 1] * hi16(x0[i]);
                    u[8 + 2 * i] += CW[q * 64 + ppart * 16 + 8 + 2 * i] * lo16(x1[i]); u[8 + 2 * i + 1] += CW[q * 64 + ppart * 16 + 8 + 2 * i + 1] * hi16(x1[i]);
                }
            }
            u4v w0, w1;
#pragma unroll
            for (int i = 0; i < 4; ++i) { w0[i] = pk2(u[2 * i], u[2 * i + 1]); w1[i] = pk2(u[8 + 2 * i], u[8 + 2 * i + 1]); }
            *(u4v*)(Us + ptok * GP + ppart * 16) = w0; *(u4v*)(Us + ptok * GP + ppart * 16 + 8) = w1;
        }
        lds_barrier();
        {
            f4v ga[4], gx[4];
#pragma unroll
            for (int nj = 0; nj < 4; ++nj) { ga[nj] = (f4v){0.f, 0.f, 0.f, 0.f}; gx[nj] = (f4v){0.f, 0.f, 0.f, 0.f}; }
#pragma unroll
            for (int ks = 0; ks < 2; ++ks) {
                const s8v af = *(const s8v*)(Us + (wave * 16 + l15) * GP + ks * 32 + gq * 8);
#pragma unroll
                for (int nj = 0; nj < 4; ++nj) { ga[nj] = MFMA16(af, wfa[nj][ks], ga[nj]); gx[nj] = MFMA16(af, *(const s8v*)(WXs + (nj * 16 + l15) * GP + ks * 32 + gq * 8), gx[nj]); }
            }
#pragma unroll
            for (int nj = 0; nj < 4; ++nj)
#pragma unroll
                for (int q = 0; q < 4; ++q) {
                    const int tok = wave * 16 + gq * 4 + q, ch = nj * 16 + l15;
                    const float uu = bf2f(Us[tok * GP + ch]);
                    const float rg = __builtin_amdgcn_rcpf(1.f + __expf(-(ga[nj][q] + cba[nj]))), ig = __builtin_amdgcn_rcpf(1.f + __expf(-(gx[nj][q] + cbx[nj])));
                    const float av_ = __expf(-8.f * rg * csp[nj]);
                    Aa[tok * 64 + ch] = av_;
                    Bb[tok * 64 + ch] = __builtin_amdgcn_sqrtf(fmaxf(1.f - av_ * av_, 0.f)) * (ig * uu);
                }
        }
        lds_barrier();
        {
            const int tb = dir ? (63 - wave * 16) : wave * 16;
            const int a0 = tb * 64 + lane;
            float ap = 1.f, hl = 0.f;
            if (dir) seg_aggr<-64>(Aa, Bb, a0, ap, hl); else seg_aggr<64>(Aa, Bb, a0, ap, hl);
            SAg[wave * 64 + lane] = ap; SBg[wave * 64 + lane] = hl;
            lds_barrier();
            float hin = h, ainw = ain, hc = h, ac = ain;
#pragma unroll
            for (int w2 = 0; w2 < 4; ++w2) { if (w2 == wave) { hin = hc; ainw = ac; } const float sa = SAg[w2 * 64 + lane]; hc = sa * hc + SBg[w2 * 64 + lane]; ac *= sa; }
            h = hc; ain = ac;
            if (dir) seg_apply<-64>(Aa, Bb, a0, hin, ainw); else seg_apply<64>(Aa, Bb, a0, hin, ainw);
        }
        lds_barrier();
        {
#pragma unroll
            for (int i = 0; i < 4; ++i) {
                *(f4v*)(HL + (size_t)(jlo + ptok) * 256 + ppart * 16 + i * 4) = *(const f4v*)(Aa + ptok * 64 + ppart * 16 + i * 4);
                *(f4v*)(AC + (size_t)(jlo + ptok) * 256 + ppart * 16 + i * 4) = *(const f4v*)(Bb + ptok * 64 + ppart * 16 + i * 4);
            }
        }
        if (c + 1 < cbeg + LRU_SEGC) {
#pragma unroll
            for (int i = 0; i < 3; ++i) if (lr + 32 * i < 68) *(u4v*)(Xs + (lr + 32 * i) * 64 + lc * 8) = rx[i];
        }
    }
    if (wave == 0) {
        float* ag = (float*)(p.ws + WS_AGG) + ((size_t)(((b * 4 + n) * 2 + dir) * LRU_NSEG + seg)) * 128;
        ag[lane] = h; ag[64 + lane] = ain;
    }
    lds_barrier();
}

__device__ __forceinline__ void phase_lru_combine(const Params& p, int l) {
    const int tid = tid_op();
    const float* HLb = (const float*)(p.ws + WS_HF);
    const float* HLb1 = (const float*)(p.ws + WS_H);
    const float* AG = (const float*)(p.ws + WS_AGG);
    const bf16* Zb = (const bf16*)(p.ws + WS_Z);
    bf16* Yb = (bf16*)(p.ws + WS_Y);
    for (int u = blockIdx.x * 256 + tid; u < M * 32; u += gridDim.x * 256) {
        const int r = u >> 5, g = u & 31, b = r / TB, j = r - b * TB;
        if (l == 1 && j < LC) continue;
        const int ch0 = g * 8, n = ch0 >> 6, cl = ch0 & 63;
        const int seg0 = (j >> 6) / LRU_SEGC;
        const int c1 = (j < LC) ? 3 - (j >> 6) : 135 - (j >> 6);
        const int seg1 = c1 / LRU_SEGC;
        float car0[8], car1[8];
#pragma unroll
        for (int i = 0; i < 8; ++i) { car0[i] = 0.f; car1[i] = 0.f; }
        for (int s = 0; s < seg0; ++s) {
            const float* ag = AG + ((size_t)(((b * 4 + n) * 2 + 0) * LRU_NSEG + s)) * 128 + cl;
#pragma unroll
            for (int i = 0; i < 8; ++i) car0[i] = ag[64 + i] * car0[i] + ag[i];
        }
        for (int s = 0; s < seg1; ++s) {
            const float* ag = AG + ((size_t)(((b * 4 + n) * 2 + 1) * LRU_NSEG + s)) * 128 + cl;
#pragma unroll
            for (int i = 0; i < 8; ++i) car1[i] = ag[64 + i] * car1[i] + ag[i];
        }
        const size_t ro = (size_t)r * 256 + ch0;
        const f4v h0a = *(const f4v*)(HLb + ro), h0b = *(const f4v*)(HLb + ro + 4);
        const f4v a0a = *(const f4v*)(HLb + (size_t)M * 256 + ro), a0b = *(const f4v*)(HLb + (size_t)M * 256 + ro + 4);
        const f4v h1a = *(const f4v*)(HLb1 + ro), h1b = *(const f4v*)(HLb1 + ro + 4);
        const f4v a1a = *(const f4v*)(HLb1 + (size_t)M * 256 + ro), a1b = *(const f4v*)(HLb1 + (size_t)M * 256 + ro + 4);
        const u4v xg = *(const u4v*)(Zb + (size_t)r * ZP + ZXG + ch0);
        float y[8];
#pragma unroll
        for (int i = 0; i < 4; ++i) {
            y[i] = (h0a[i] + a0a[i] * car0[i]) + (h1a[i] + a1a[i] * car1[i]);
            y[4 + i] = (h0b[i] + a0b[i] * car0[4 + i]) + (h1b[i] + a1b[i] * car1[4 + i]);
        }
        u4v o;
#pragma unroll
        for (int i = 0; i < 4; ++i) o[i] = pk2(y[2 * i] * gelu_t(lo16(xg[i])), y[2 * i + 1] * gelu_t(hi16(xg[i])));
        *(u4v*)(Yb + (size_t)r * D + 768 + ch0) = o;
    }
}

__device__ __forceinline__ void phase_mixers_fast(const Params& p, int l, unsigned char* smem, int* s_item, int ctr_off) {
    const int tid = threadIdx.x;
    float* biasLds = (float*)(smem + BIAS_OFF_B);
    for (int i = tid; i < 4 * 465; i += 256) biasLds[i] = p.na_bias[(size_t)l * 4 * 465 + i];
    unsigned* ctr = (unsigned*)(p.ws + WS_CTL) + l + ctr_off;
    const int nctx = (l == 0) ? 48 : 0;
    const int total = 512 + LRU_ITEMS + 2 * 512 + nctx;
    __syncthreads();
    while (true) {
        if (tid == 0) *s_item = (int)atomicAdd(ctr, 1u);
        __syncthreads();
        const int item = *s_item;
        __syncthreads();
        if (item >= total) break;
        if (item < 512) {
            const int b = item >> 7, rem = item & 127;
            attn_item_fast<1>(p, l, b, rem >> 6, rem & 63, false, (bf16*)smem, biasLds);
        } else if (item < 512 + LRU_ITEMS) {
            const int v = item - 512;
            const int seg = v % LRU_NSEG, w = v / LRU_NSEG;
            lru_item_fast(p, l, w >> 3, (w >> 1) & 3, w & 1, seg, smem);
        } else if (item < 512 + LRU_ITEMS + 1024) {
            const int v = item - 512 - LRU_ITEMS, idx = v & 511;
            const int b = idx >> 7, rem = idx & 127;
            if (v < 512) attn_item_fast<2>(p, l, b, rem >> 5, rem & 31, false, (bf16*)smem, biasLds);
            else attn_item_fast<0>(p, l, b, rem >> 6, rem & 63, false, (bf16*)smem, biasLds);
        } else {
            const int v = item - 512 - LRU_ITEMS - 1024, ko = v >> 4, rem = v & 15;
            const int kind = (ko == 0) ? 1 : (ko == 1 ? 0 : 2);
            const int b = rem >> 2, x = rem & 3;
            if (kind == 2) attn_item_fast<2>(p, l, b, x, 0, true, (bf16*)smem, biasLds);
            else if (kind == 1) attn_item_fast<1>(p, l, b, x >> 1, x & 1, true, (bf16*)smem, biasLds);
            else attn_item_fast<0>(p, l, b, x >> 1, x & 1, true, (bf16*)smem, biasLds);
        }
        __syncthreads();
    }
}

__device__ __forceinline__ void fp8x16_to_f32(const u4v w, float (&f)[16]) {
#pragma unroll
    for (int i = 0; i < 4; ++i) {
        const f2v lo = __builtin_amdgcn_cvt_pk_f32_fp8((int)w[i], false), hi = __builtin_amdgcn_cvt_pk_f32_fp8((int)w[i], true);
        f[i * 4] = lo[0]; f[i * 4 + 1] = lo[1]; f[i * 4 + 2] = hi[0]; f[i * 4 + 3] = hi[1];
    }
}
__device__ __forceinline__ float xch32(float v, int lane) {
    const unsigned b = __float_as_uint(v);
    const auto r = __builtin_amdgcn_permlane32_swap(b, b, false, false);
    return __uint_as_float((lane & 32) ? r[0] : r[1]);
}
__device__ __forceinline__ float xch16(float v, int lane) {
    const unsigned b = __float_as_uint(v);
    const auto r = __builtin_amdgcn_permlane16_swap(b, b, false, false);
    return __uint_as_float((lane & 16) ? r[0] : r[1]);
}
template <int CTRL>
__device__ __forceinline__ float dppf(float v) { return __uint_as_float((unsigned)__builtin_amdgcn_update_dpp(0, (int)__float_as_uint(v), CTRL, 0xF, 0xF, false)); }
__device__ __forceinline__ float xch8(float v) { return dppf<0x128>(v); }
__device__ __forceinline__ float xch4(float v) { return dppf<0x1B>(dppf<0x141>(v)); }
__device__ __forceinline__ float xch2(float v) { return dppf<0x4E>(v); }
__device__ __forceinline__ float xch1(float v) { return dppf<0xB1>(v); }

__device__ __forceinline__ void phase_peer(const Params& p, int l) {
    const int tidx = tid_op(), lane = tidx & 63, gw = blockIdx.x * 4 + __builtin_amdgcn_readfirstlane(tidx >> 6), nw = gridDim.x * 4;
    const bf16* H = (const bf16*)(p.ws + WS_H);
    const unsigned char* U = p.ws + WS_U + (size_t)l * NE * D;
    const unsigned char* V = p.ws + WS_V + (size_t)l * NE * D;
    const float* US = (const float*)(p.ws + WS_US) + (size_t)l * NE;
    const float* VS = (const float*)(p.ws + WS_VS) + (size_t)l * NE;
    const float* stop = (const float*)(p.ws + WS_STOP);
    const unsigned char* itop = p.ws + WS_ITOP;
    const float* modv = (const float*)(p.ws + WS_MOD);
    const int ci = (lane >= 16) + (lane >= 24) + (lane >= 29) + (lane >= 33) + (lane >= 36) + (lane >= 38) + (lane >= 40) + (lane >= 42)
                 + (lane >= 43) + (lane >= 44) + (lane >= 45) + (lane >= 46) + (lane >= 47) + (lane >= 48) + (lane >= 49);
    const int cpre = (ci == 0) ? 0 : (ci == 1) ? 16 : (ci == 2) ? 24 : (ci == 3) ? 29 : (ci == 4) ? 33 : (ci == 5) ? 36 : (ci == 6) ? 38 : (ci == 7) ? 40 : 34 + ci;
    const int cj = (lane - cpre) & 15;
    const bool cvalid = lane < 50;
    for (int r = gw; r < M; r += nw) {
        const int mi = mod_idx(r);
        if (l == 1 && mi == 4) continue;
        float hf[16];
        {
            const bf16* hrow = H + (size_t)r * D + lane * 16;
            const u4v h0 = *(const u4v*)hrow, h1 = *(const u4v*)(hrow + 8);
#pragma unroll
            for (int i = 0; i < 4; ++i) { hf[2 * i] = lo16(h0[i]); hf[2 * i + 1] = hi16(h0[i]); hf[8 + 2 * i] = lo16(h1[i]); hf[8 + 2 * i + 1] = hi16(h1[i]); }
        }
        float out[16];
#pragma unroll
        for (int i = 0; i < 16; ++i) out[i] = 0.f;
        float st_n = -3e38f; int it_n = 0;
        if (lane < 32) { st_n = stop[(size_t)r * 256 + lane]; it_n = itop[(size_t)r * 256 + lane]; }
#pragma unroll 1
        for (int hh = 0; hh < 8; ++hh) {
            const float st = st_n; const int it = it_n;
            if (hh + 1 < 8 && lane < 32) { st_n = stop[(size_t)r * 256 + (hh + 1) * 32 + lane]; it_n = itop[(size_t)r * 256 + (hh + 1) * 32 + lane]; }
            const float cand = cvalid ? __shfl(st, ci) + __shfl(st, 16 + cj) : -3e38f;
            const int ecand = __shfl(it, ci) * 128 + __shfl(it, 16 + cj);
            const unsigned key = (f2ord(cand) & ~63u) | (unsigned)(63 - lane);
            unsigned thr = 0u;
#pragma unroll
            for (int bit = 31; bit >= 0; --bit) {
                const unsigned t = thr | (1u << bit);
                if (__popcll(__ballot(key >= t)) >= 16) thr = t;
            }
            const bool sel = key >= thr;
            const unsigned long long selm = __ballot(sel);
            const unsigned long long m2 = sel ? selm : ~selm;
            const int rank = __builtin_amdgcn_mbcnt_hi((unsigned)(m2 >> 32), __builtin_amdgcn_mbcnt_lo((unsigned)m2, 0u));
            const int dst = sel ? rank : 16 + rank;
            const float smax = __uint_as_float(__builtin_amdgcn_readlane(__float_as_uint(cand), 0));
            const float mys = __uint_as_float(__builtin_amdgcn_ds_permute(dst * 4, __float_as_uint(cand)));
            const int e = __builtin_amdgcn_ds_permute(dst * 4, ecand);
            const float su = US[e], sv = VS[e];
            float ex = (lane < 16) ? __expf(mys - smax) : 0.f;
            float esum = ex;
            esum += xch8(esum); esum += xch4(esum); esum += xch2(esum); esum += xch1(esum);
            float gate = (lane < 16) ? ex / esum : 0.f;
            u4v ur[16], vr[16];
#pragma unroll
            for (int k = 0; k < 16; ++k) { const int ek = __builtin_amdgcn_readlane(e, k); ur[k] = *(const u4v*)(U + (size_t)ek * D + lane * 16); }
#pragma unroll
            for (int k = 0; k < 16; ++k) { const int ek = __builtin_amdgcn_readlane(e, k); vr[k] = *(const u4v*)(V + (size_t)ek * D + lane * 16); }
            float part[16];
#pragma unroll
            for (int k = 0; k < 16; ++k) {
                f2v a2 = {0.f, 0.f};
#pragma unroll
                for (int i = 0; i < 4; ++i) {
                    const f2v lo = __builtin_amdgcn_cvt_pk_f32_fp8((int)ur[k][i], false), hi = __builtin_amdgcn_cvt_pk_f32_fp8((int)ur[k][i], true);
                    a2 += lo * (f2v){hf[i * 4], hf[i * 4 + 1]};
                    a2 += hi * (f2v){hf[i * 4 + 2], hf[i * 4 + 3]};
                }
                part[k] = a2[0] + a2[1];
            }
            float q8[8], q4[4], q2[2], q1;
            { const bool hi = (lane & 32) != 0;
#pragma unroll
              for (int k = 0; k < 8; ++k) { float send = hi ? part[k] : part[k + 8], keep = hi ? part[k + 8] : part[k]; q8[k] = keep + xch32(send, lane); } }
            { const bool hi = (lane & 16) != 0;
#pragma unroll
              for (int k = 0; k < 4; ++k) { float send = hi ? q8[k] : q8[k + 4], keep = hi ? q8[k + 4] : q8[k]; q4[k] = keep + xch16(send, lane); } }
            { const bool hi = (lane & 8) != 0;
#pragma unroll
              for (int k = 0; k < 2; ++k) { float send = hi ? q4[k] : q4[k + 2], keep = hi ? q4[k + 2] : q4[k]; q2[k] = keep + xch8(send); } }
            { const bool hi = (lane & 4) != 0; float send = hi ? q2[0] : q2[1], keep = hi ? q2[1] : q2[0]; q1 = keep + xch4(send); }
            q1 += xch2(q1); q1 += xch1(q1);
            const int kk = (lane >> 2) & 15;
            const float coef = gelu_t(q1 * __shfl(su, kk)) * __shfl(gate, kk) * __shfl(sv, kk);
#pragma unroll
            for (int k = 0; k < 16; ++k) {
                const float ck = __uint_as_float(__builtin_amdgcn_readlane(__float_as_uint(coef), 4 * k));
                float vf[16];
                fp8x16_to_f32(vr[k], vf);
#pragma unroll
                for (int i = 0; i < 16; ++i) out[i] += ck * vf[i];
            }
        }
        float* xr = xs_row(p, r) + lane * 16;
        float xv[16];
#pragma unroll
        for (int i = 0; i < 4; ++i) { const float4 t = *(const float4*)(xr + i * 4); xv[i * 4] = t.x; xv[i * 4 + 1] = t.y; xv[i * 4 + 2] = t.z; xv[i * 4 + 3] = t.w; }
        const float* mv = modv + ((size_t)l * 5 + mi) * 6144;
#pragma unroll
        for (int i = 0; i < 16; ++i) xv[i] += mv[5120 + lane * 16 + i] * out[i];
        float ss = 0.f;
#pragma unroll
        for (int i = 0; i < 16; ++i) ss += xv[i] * xv[i];
        ss = wave_sum(ss);
        const float rstd = rsqrtf(ss * (1.f / 1024.f) + EPS);
        if (l == 0) {
#pragma unroll
            for (int i = 0; i < 4; ++i) *(float4*)(xr + i * 4) = make_float4(xv[i * 4], xv[i * 4 + 1], xv[i * 4 + 2], xv[i * 4 + 3]);
            const float* mv1 = modv + ((size_t)1 * 5 + mi) * 6144;
            const float* g = p.norm_mix + D;
            float o[16];
#pragma unroll
            for (int i = 0; i < 16; ++i) { const int e0 = lane * 16 + i; o[i] = xv[i] * rstd * g[e0] * (1.f + mv1[1024 + e0]) + mv1[e0]; }
            u4v w0, w1;
#pragma unroll
            for (int i = 0; i < 4; ++i) { w0[i] = pk2(o[2 * i], o[2 * i + 1]); w1[i] = pk2(o[8 + 2 * i], o[8 + 2 * i + 1]); }
            bf16* hrow = (bf16*)(p.ws + WS_H) + (size_t)r * D + lane * 16;
            *(u4v*)hrow = w0; *(u4v*)(hrow + 8) = w1;
        } else {
#pragma unroll
            for (int i = 0; i < 4; ++i) {
                const float4 g4 = *(const float4*)(p.norm_final + lane * 16 + i * 4);
                *(float4*)(xr + i * 4) = make_float4(xv[i * 4] * rstd * g4.x, xv[i * 4 + 1] * rstd * g4.y, xv[i * 4 + 2] * rstd * g4.z, xv[i * 4 + 3] * rstd * g4.w);
            }
        }
    }
}

__device__ __forceinline__ void grid_bar(unsigned* ctl, unsigned& gen) {
    __syncthreads();
    gen += 1;
    unsigned* arrive = ctl + 256;
    unsigned* release = ctl + 896;
    if (threadIdx.x == 0) {
        __threadfence();
        __hip_atomic_store(arrive + blockIdx.x, gen, __ATOMIC_RELAXED, __HIP_MEMORY_SCOPE_AGENT);
    }
    if (blockIdx.x == 0) {
        for (unsigned i = threadIdx.x; i < gridDim.x; i += 256)
            while (__hip_atomic_load(arrive + i, __ATOMIC_RELAXED, __HIP_MEMORY_SCOPE_AGENT) < gen) __builtin_amdgcn_s_sleep(1);
        __syncthreads();
        if (threadIdx.x == 0) __hip_atomic_store(release, gen, __ATOMIC_RELAXED, __HIP_MEMORY_SCOPE_AGENT);
    }
    if (threadIdx.x == 0) {
        while (__hip_atomic_load(release, __ATOMIC_RELAXED, __HIP_MEMORY_SCOPE_AGENT) < gen) __builtin_amdgcn_s_sleep(1);
        __threadfence();
    }
    __syncthreads();
}

#ifndef DUP_MASK
#define DUP_MASK 0
#endif
__global__ void __launch_bounds__(256, 2) fwd_megakernel(Params p) {
    __shared__ __attribute__((aligned(16))) unsigned char smem[SMEM_BYTES];
    float* lds = (float*)smem;
    __shared__ int s_item;
    cg::grid_group grid = cg::this_grid();
    unsigned* gbar = (unsigned*)(p.ws + WS_CTL);
    unsigned gtarget = 0;
    phase0(p, lds);
    grid.sync();
    if (DUP_MASK & 1) { phase0(p, lds); grid_bar(gbar, gtarget); }
    phase_rownorm(p, 0, 0);
    grid_bar(gbar, gtarget);
#pragma unroll 1
    for (int l = 0; l < 2; ++l) {
        phase_inproj_fast(p, l, (bf16*)smem);
        grid_bar(gbar, gtarget);
        if (DUP_MASK & 2) { phase_inproj_fast(p, l, (bf16*)smem); grid_bar(gbar, gtarget); }
        phase_mixers_fast(p, l, smem, &s_item, 0);
        grid_bar(gbar, gtarget);
        if (DUP_MASK & 4) { phase_mixers_fast(p, l, smem, &s_item, 2); grid_bar(gbar, gtarget); }
        phase_lru_combine(p, l);
        grid_bar(gbar, gtarget);
        phase_outproj_fast(p, l, (bf16*)smem);
        grid_bar(gbar, gtarget);
        if ((DUP_MASK & 32) && l == 0) { phase_outproj_fast(p, l, (bf16*)smem); grid_bar(gbar, gtarget); }
        phase_rownorm(p, l, 1);
        grid_bar(gbar, gtarget);
        if (DUP_MASK & 16) { phase_rownorm(p, l, 1); grid_bar(gbar, gtarget); }
        phase_peerq_fast(p, l, (bf16*)smem);
        grid_bar(gbar, gtarget);
        if (DUP_MASK & 8) { phase_peerq_fast(p, l, (bf16*)smem); grid_bar(gbar, gtarget); }
        phase_peer(p, l);
        if (l == 0) grid_bar(gbar, gtarget);
    }
}

extern "C" void kernel_launch(void* const* d_in, const int* in_sizes, int n_in, void* d_out, int out_size, void* d_ws, size_t ws_size, hipStream_t stream) {
    static int grid_blocks = 0;
    if (!grid_blocks) {
        int dev = 0, cus = 0, per_cu = 0;
        hipGetDevice(&dev);
        hipDeviceGetAttribute(&cus, hipDeviceAttributeMultiprocessorCount, dev);
        hipOccupancyMaxActiveBlocksPerMultiprocessor(&per_cu, fwd_megakernel, 256, 0);
        if (per_cu > 2) per_cu = 2;
        if (per_cu < 1) per_cu = 1;
        grid_blocks = cus * per_cu;
        if (grid_blocks > 512) grid_blocks = 512;
        if (ws_size < WS_END) fprintf(stderr, "kernel_launch: workspace too small: need %zu have %zu\n", (size_t)WS_END, ws_size);
    }
    Params p{};
    const float** pp = (const float**)&p;
    for (int i = 0; i < 26; ++i) pp[i] = (const float*)d_in[i];
    p.out = (float*)d_out;
    p.ws = (unsigned char*)d_ws;
    (void)hipMemsetAsync((char*)d_ws + WS_CTL, 0, 4096, stream);
    void* args[] = {&p};
    hipError_t e = hipLaunchCooperativeKernel((void*)fwd_megakernel, dim3(grid_blocks), dim3(256), args, 0, stream);
    if (e != hipSuccess) fprintf(stderr, "cooperative launch failed: %s (grid %d)\n", hipGetErrorString(e), grid_blocks);
}
```
